# Optimizing an MI355X kernel written in HIP

```python
import math
import jax, jax.numpy as jnp
from jax import lax
import numpy as np

D_MODEL = 2048
BATCH = 8
SEQ = 2048
DEPTH = 2

GRID_W = 64
CTX_LEN = 256
MIX_W = D_MODEL
DIFF_W = MIX_W // 4
GQA_W = MIX_W // 2
RET_W = MIX_W - DIFF_W - GQA_W
DIFF_DV = 128
DIFF_DK = DIFF_DV // 2
DIFF_HEADS = DIFF_W // DIFF_DV
GQA_DH = 128
GQA_HEADS = GQA_W // GQA_DH
GQA_KV_HEADS = GQA_HEADS // 4
GQA_GROUP = GQA_HEADS // GQA_KV_HEADS
RET_DV = 128
RET_DK = RET_DV // 2
RET_HEADS = RET_W // RET_DV
RET_CHUNK = 128
Q_BLOCK = 128
ROPE_BASE = 10000.0
NORM_EPS = 1e-6
N_KEYS = 128
N_EXPERTS = N_KEYS * N_KEYS
PEER_HEADS = 8
PEER_TOPK = 16
PEER_QDIM = 256
PEER_HALF = PEER_QDIM // 2
PEER_TOKEN_BLOCK = 128
Q_SIZES = (DIFF_HEADS * 2 * DIFF_DK, GQA_HEADS * GQA_DH, RET_HEADS * RET_DK, RET_W)
KV_SIZES = (DIFF_HEADS * 2 * DIFF_DK, DIFF_W, GQA_KV_HEADS * GQA_DH, GQA_KV_HEADS * GQA_DH, RET_HEADS * RET_DK, RET_W)
Q_COLS = sum(Q_SIZES)
KV_COLS = sum(KV_SIZES)
IN_COLS = Q_COLS + KV_COLS

kernel_name = "hybrid_diff_gqa_retention_peer_dit"


def rms_norm(x, g):
    xf = x.astype(jnp.float32)
    y = xf * lax.rsqrt(jnp.mean(xf * xf, axis=-1, keepdims=True) + NORM_EPS)
    return (y * g.astype(jnp.float32)).astype(x.dtype)


def modulate(x, g, shift, scale):
    return rms_norm(x, g) * (1 + scale) + shift


def split_cols(a, sizes):
    offsets, acc = [], 0
    for s in sizes[:-1]:
        acc += s
        offsets.append(acc)
    return jnp.split(a, offsets, axis=-1)


def split_heads(a, n_heads, dh):
    b, t = a.shape[:2]
    return a.reshape(b, t, n_heads, dh).transpose(0, 2, 1, 3)


def merge_heads(a):
    b, h, t, d = a.shape
    return a.transpose(0, 2, 1, 3).reshape(b, t, h * d)


def axial_rope(rows, head_dim):
    t = jnp.arange(rows * GRID_W)
    row = (t // GRID_W).astype(jnp.float32)
    col = (t % GRID_W).astype(jnp.float32)
    d_axis = head_dim // 2
    inv_freq = ROPE_BASE ** (-jnp.arange(0, d_axis, 2, dtype=jnp.float32) / d_axis)
    ang = jnp.concatenate([row[:, None] * inv_freq, col[:, None] * inv_freq], axis=-1)
    return jnp.cos(ang), jnp.sin(ang)


def apply_rope(x, cos, sin):
    xf = x.astype(jnp.float32)
    x1, x2 = xf[..., 0::2], xf[..., 1::2]
    out = jnp.stack([x1 * cos - x2 * sin, x1 * sin + x2 * cos], axis=-1).reshape(x.shape)
    return out.astype(x.dtype)


def sweep_query_blocks(fn, q):
    n_q = q.shape[-2]
    qb = q.reshape(q.shape[:-2] + (n_q // Q_BLOCK, Q_BLOCK, q.shape[-1]))
    qb = jnp.moveaxis(qb, -3, 0)
    ob = lax.map(fn, qb)
    ob = jnp.moveaxis(ob, 0, -3)
    return ob.reshape(ob.shape[:-3] + (n_q, ob.shape[-1]))


def diff_attention(q, k, v, lam):
    scale = DIFF_DK ** -0.5

    def block(qb):
        s = jnp.einsum('bhmqd,bhmkd->bhmqk', qb, k).astype(jnp.float32) * scale
        a = jax.nn.softmax(s, axis=-1)
        a = a[:, :, 0] - lam * a[:, :, 1]
        return jnp.einsum('bhqk,bhkd->bhqd', a.astype(v.dtype), v)

    return sweep_query_blocks(block, q)


def gqa_attention(q, k, v):
    scale = GQA_DH ** -0.5

    def block(qb):
        s = jnp.einsum('bhgqd,bhkd->bhgqk', qb, k).astype(jnp.float32) * scale
        a = jax.nn.softmax(s, axis=-1)
        return jnp.einsum('bhgqk,bhkd->bhgqd', a.astype(v.dtype), v)

    return sweep_query_blocks(block, q)


def retention_scan(q, k, v, log_gamma, state0, include_diag):
    b, h, t, _ = q.shape
    dv = v.shape[-1]
    n_chunks = t // RET_CHUNK
    pos = jnp.arange(RET_CHUNK, dtype=jnp.float32)
    rel = pos[:, None] - pos[None, :]
    keep = (rel >= 0) if include_diag else (rel > 0)
    inner_decay = jnp.where(keep, jnp.exp(log_gamma[:, None, None] * jnp.where(keep, rel, 0.0)), 0.0)
    q_decay = jnp.exp(log_gamma[:, None] * (pos + 1.0))[..., None]
    k_decay = jnp.exp(log_gamma[:, None] * (RET_CHUNK - 1.0 - pos))[..., None]
    chunk_decay = jnp.exp(log_gamma * RET_CHUNK)[:, None, None]

    def to_chunks(a):
        return jnp.moveaxis(a.reshape(b, h, n_chunks, RET_CHUNK, a.shape[-1]), 2, 0)

    def step(state, qkv):
        qc, kc, vc = qkv
        attn = jnp.einsum('bhid,bhjd->bhij', qc, kc) * inner_decay
        out = (jnp.einsum('bhij,bhjv->bhiv', attn, vc)
               + jnp.einsum('bhid,bhdv->bhiv', qc * q_decay, state))
        state = state * chunk_decay + jnp.einsum('bhjd,bhjv->bhdv', kc * k_decay, vc)
        return state, out

    _, out = lax.scan(step, state0, (to_chunks(q), to_chunks(k), to_chunks(v)))
    return jnp.moveaxis(out, 0, 2).reshape(b, h, t, dv)


def retention_final_state(k, v, log_gamma, reverse):
    kf, vf = k.astype(jnp.float32), v.astype(jnp.float32)
    t = jnp.arange(k.shape[2], dtype=jnp.float32)
    dist = t if reverse else (k.shape[2] - 1.0 - t)
    w = jnp.exp(log_gamma[:, None] * dist[None, :])[..., None]
    return jnp.einsum('bhtd,bhtv->bhdv', kf * w, vf)


def retention_bidir(q, k, v, gate, log_g, state_f, state_b, out_g):
    qf, kf, vf = q.astype(jnp.float32), k.astype(jnp.float32), v.astype(jnp.float32)
    fwd = retention_scan(qf, kf, vf, log_g[0], state_f, True)
    bwd = jnp.flip(retention_scan(jnp.flip(qf, 2), jnp.flip(kf, 2), jnp.flip(vf, 2), log_g[1], state_b, False), 2)
    y = merge_heads(rms_norm(fwd + bwd, out_g)).astype(v.dtype)
    return jax.nn.silu(gate) * y


def diff_qk_heads(a, g):
    b, t = a.shape[:2]
    a = a.reshape(b, t, DIFF_HEADS, 2, DIFF_DK).transpose(0, 2, 3, 1, 4)
    return rms_norm(a, g)


def q_heads(q_side, rope_diff, rope_gqa, diff_q_norm_g, gqa_q_norm_g):
    dq, gq, rq, rgate = split_cols(q_side, Q_SIZES)
    b, t = q_side.shape[:2]
    dq = diff_qk_heads(dq, diff_q_norm_g)
    gq = rms_norm(gq.reshape(b, t, GQA_KV_HEADS, GQA_GROUP, GQA_DH).transpose(0, 2, 3, 1, 4), gqa_q_norm_g)
    if rope_diff is not None:
        dq = apply_rope(dq, *rope_diff)
        gq = apply_rope(gq, *rope_gqa)
    return dq, gq, split_heads(rq, RET_HEADS, RET_DK), rgate


def kv_heads(kv_side, rope_diff, rope_gqa, diff_k_norm_g, gqa_k_norm_g):
    dk, dv, gk, gv, rk, rv = split_cols(kv_side, KV_SIZES)
    dk = diff_qk_heads(dk, diff_k_norm_g)
    gk = rms_norm(split_heads(gk, GQA_KV_HEADS, GQA_DH), gqa_k_norm_g)
    if rope_diff is not None:
        dk = apply_rope(dk, *rope_diff)
        gk = apply_rope(gk, *rope_gqa)
    return (dk, split_heads(dv, DIFF_HEADS, DIFF_DV), gk, split_heads(gv, GQA_KV_HEADS, GQA_DH),
            split_heads(rk, RET_HEADS, RET_DK) * (RET_DK ** -0.5), split_heads(rv, RET_HEADS, RET_DV))


def mix_tokens(qh, attn_kv, ret_kv, ret_states, lam, lam_init, log_g, w_out, diff_out_norm_g, ret_out_norm_g):
    dq, gq, rq, rgate = qh
    dk, dv, gk, gv = attn_kv
    rk, rv = ret_kv
    o_diff = merge_heads(rms_norm(diff_attention(dq, dk, dv, lam), diff_out_norm_g) * (1.0 - lam_init))
    o_gqa = gqa_attention(gq, gk, gv)
    b, _, _, t, _ = o_gqa.shape
    o_gqa = o_gqa.transpose(0, 3, 1, 2, 4).reshape(b, t, GQA_W)
    o_ret = retention_bidir(rq, rk, rv, rgate, log_g, ret_states[0], ret_states[1], ret_out_norm_g)
    return jnp.concatenate([o_diff, o_gqa, o_ret], axis=-1) @ w_out


def peer(h, w_q, sub_keys, u, v):
    b, t, d = h.shape
    hf = h.reshape(-1, d)
    n_tok = hf.shape[0]
    q = (hf @ w_q).reshape(n_tok, PEER_HEADS, 2, PEER_HALF)
    s = jnp.einsum('nhpd,hpkd->nhpk', q, sub_keys).astype(jnp.float32)
    s1, i1 = lax.top_k(s[:, :, 0], PEER_TOPK)
    s2, i2 = lax.top_k(s[:, :, 1], PEER_TOPK)
    cand = (s1[..., :, None] + s2[..., None, :]).reshape(n_tok, PEER_HEADS, PEER_TOPK * PEER_TOPK)
    cand_idx = (i1[..., :, None] * N_KEYS + i2[..., None, :]).reshape(n_tok, PEER_HEADS, PEER_TOPK * PEER_TOPK)
    top_s, pos = lax.top_k(cand, PEER_TOPK)
    idx = jnp.take_along_axis(cand_idx, pos, axis=-1)
    gates = jax.nn.softmax(top_s, axis=-1).astype(h.dtype)
    nb = n_tok // PEER_TOKEN_BLOCK

    def block(args):
        xb, ib, gb = args
        act = jax.nn.gelu(jnp.einsum('td,thkd->thk', xb, u[ib]), approximate=False) * gb
        return jnp.einsum('thk,thkd->td', act, v[ib])

    out = lax.map(block, (hf.reshape(nb, PEER_TOKEN_BLOCK, d),
                          idx.reshape(nb, PEER_TOKEN_BLOCK, PEER_HEADS, PEER_TOPK),
                          gates.reshape(nb, PEER_TOKEN_BLOCK, PEER_HEADS, PEER_TOPK)))
    return out.reshape(b, t, d)


def trunk_layer(x, ctx, c, c_ctx, layer_idx, update_ctx, rope_diff, rope_gqa,
                norm1_g, norm2_g, w_mod, b_mod, w_in, w_out,
                diff_q_norm_g, diff_k_norm_g, diff_lambda, diff_out_norm_g,
                gqa_q_norm_g, gqa_k_norm_g, ret_decay_logit, ret_out_norm_g,
                peer_w_q, peer_sub_keys, peer_u, peer_v):
    lam_init = 0.8 - 0.6 * math.exp(-0.3 * layer_idx)
    lp = diff_lambda.astype(jnp.float32)
    lam = jnp.exp(jnp.sum(lp[0] * lp[1])) - jnp.exp(jnp.sum(lp[2] * lp[3])) + lam_init
    log_g = jax.nn.log_sigmoid(ret_decay_logit.astype(jnp.float32))

    mod = jax.nn.silu(c) @ w_mod + b_mod
    sh1, sc1, g1, sh2, sc2, g2 = jnp.split(mod[:, None, :], 6, axis=-1)
    n_ctx_mod = 6 if update_ctx else 2
    mods_c = jnp.split(jax.nn.silu(c_ctx) @ w_mod[:, :n_ctx_mod * D_MODEL] + b_mod[:n_ctx_mod * D_MODEL], n_ctx_mod)

    h = modulate(x, norm1_g, sh1, sc1)
    hc = modulate(ctx, norm1_g, mods_c[0], mods_c[1])

    kv_c = kv_heads(hc @ w_in[:, Q_COLS:], None, None, diff_k_norm_g, gqa_k_norm_g)
    ctx_states = (retention_final_state(kv_c[4], kv_c[5], log_g[0], False),
                  retention_final_state(kv_c[4], kv_c[5], log_g[1], True))

    q_l = q_heads(h @ w_in[:, :Q_COLS], rope_diff, rope_gqa, diff_q_norm_g, gqa_q_norm_g)
    kv_l = kv_heads(h @ w_in[:, Q_COLS:], rope_diff, rope_gqa, diff_k_norm_g, gqa_k_norm_g)
    attn_kv_l = tuple(jnp.concatenate([a_c, a_l], axis=-2) for a_c, a_l in zip(kv_c[:4], kv_l[:4]))
    mix_l = mix_tokens(q_l, attn_kv_l, kv_l[4:], ctx_states, lam, lam_init, log_g, w_out,
                       diff_out_norm_g, ret_out_norm_g)
    x = x + g1 * mix_l
    x = x + g2 * peer(modulate(x, norm2_g, sh2, sc2), peer_w_q, peer_sub_keys, peer_u, peer_v)

    if update_ctx:
        q_c = q_heads(hc @ w_in[:, :Q_COLS], None, None, diff_q_norm_g, gqa_q_norm_g)
        zero = jnp.zeros((ctx.shape[0], RET_HEADS, RET_DK, RET_DV), jnp.float32)
        mix_c = mix_tokens(q_c, kv_c[:4], kv_c[4:], (zero, zero), lam, lam_init, log_g, w_out,
                           diff_out_norm_g, ret_out_norm_g)
        ctx = ctx + mods_c[2] * mix_c
        ctx = ctx + mods_c[5] * peer(modulate(ctx, norm2_g, mods_c[3], mods_c[4]),
                                     peer_w_q, peer_sub_keys, peer_u, peer_v)
    return x, ctx


def setup_inputs(seed: int = 0) -> dict:
    key = jax.random.key(seed)
    ks = jax.random.split(key, 24)
    f32 = jnp.float32

    def nrm(k, shape, s):
        return jax.random.normal(k, shape, f32) * s

    def gain(k, shape):
        return 1.0 + 0.02 * jax.random.normal(k, shape, f32)

    base_logit = jnp.log(2.0 ** (5.0 + jnp.arange(RET_HEADS, dtype=f32)) - 1.0)
    return {
        "x": nrm(ks[0], (BATCH, SEQ, D_MODEL), 1.0),
        "c": nrm(ks[1], (BATCH, D_MODEL), 1.0),
        "ctx": nrm(ks[2], (BATCH, CTX_LEN, D_MODEL), 1.0),
        "c_ctx": nrm(ks[3], (D_MODEL,), 1.0),
        "norm1_g": gain(ks[4], (DEPTH, D_MODEL)),
        "norm2_g": gain(ks[5], (DEPTH, D_MODEL)),
        "w_mod": nrm(ks[6], (DEPTH, D_MODEL, 6 * D_MODEL), 0.5 * D_MODEL ** -0.5),
        "b_mod": nrm(ks[7], (DEPTH, 6 * D_MODEL), 0.01),
        "w_in": nrm(ks[8], (DEPTH, D_MODEL, IN_COLS), D_MODEL ** -0.5),
        "w_out": nrm(ks[9], (DEPTH, MIX_W, D_MODEL), MIX_W ** -0.5),
        "diff_q_norm_g": gain(ks[10], (DEPTH, DIFF_DK)),
        "diff_k_norm_g": gain(ks[11], (DEPTH, DIFF_DK)),
        "diff_lambda": nrm(ks[12], (DEPTH, 4, DIFF_DK), 0.1),
        "diff_out_norm_g": gain(ks[13], (DEPTH, DIFF_DV)),
        "gqa_q_norm_g": gain(ks[14], (DEPTH, GQA_DH)),
        "gqa_k_norm_g": gain(ks[15], (DEPTH, GQA_DH)),
        "ret_decay_logit": base_logit + nrm(ks[16], (DEPTH, 2, RET_HEADS), 0.05),
        "ret_out_norm_g": gain(ks[17], (DEPTH, RET_DV)),
        "peer_w_q": nrm(ks[18], (DEPTH, D_MODEL, PEER_HEADS * PEER_QDIM), D_MODEL ** -0.5),
        "peer_sub_keys": nrm(ks[19], (DEPTH, PEER_HEADS, 2, N_KEYS, PEER_HALF), PEER_HALF ** -0.5),
        "peer_u": nrm(ks[20], (DEPTH, N_EXPERTS, D_MODEL), D_MODEL ** -0.5),
        "peer_v": nrm(ks[21], (DEPTH, N_EXPERTS, D_MODEL), 1.0),
    }


def reference(x, c, ctx, c_ctx, norm1_g, norm2_g, w_mod, b_mod, w_in, w_out,
              diff_q_norm_g, diff_k_norm_g, diff_lambda, diff_out_norm_g,
              gqa_q_norm_g, gqa_k_norm_g, ret_decay_logit, ret_out_norm_g,
              peer_w_q, peer_sub_keys, peer_u, peer_v):
    rows = x.shape[1] // GRID_W
    rope_diff = axial_rope(rows, DIFF_DK)
    rope_gqa = axial_rope(rows, GQA_DH)
    for l in range(DEPTH):
        x, ctx = trunk_layer(x, ctx, c, c_ctx, l, l < DEPTH - 1, rope_diff, rope_gqa,
                             norm1_g[l], norm2_g[l], w_mod[l], b_mod[l], w_in[l], w_out[l],
                             diff_q_norm_g[l], diff_k_norm_g[l], diff_lambda[l], diff_out_norm_g[l],
                             gqa_q_norm_g[l], gqa_k_norm_g[l], ret_decay_logit[l], ret_out_norm_g[l],
                             peer_w_q[l], peer_sub_keys[l], peer_u[l], peer_v[l])
    return x
```

```cpp
#include <hip/hip_runtime.h>
#include <hip/hip_bf16.h>
#include <cstdio>
#include <cstdint>
#include <cmath>

namespace pg8 {
#define PG8_LAS __attribute__((address_space(3)))
typedef unsigned short bf16_t;
typedef short bf16x8 __attribute__((ext_vector_type(8)));
typedef float f32x4 __attribute__((ext_vector_type(4)));
typedef unsigned u32x4 __attribute__((ext_vector_type(4)));
constexpr int BM = 256, BK = 64, HALF = 128, HTB = HALF * BK * 2  , STAGE_BYTES = 8 * HTB, NXCD = 8, WGM = 8;

__host__ __device__ __forceinline__ int lds_byte(int r, int c) { const int st = (r >> 4) * 2 + (c >> 5), rr = r & 15, cc = c & 31, ob = rr * 64 + cc * 2; return st * 1024 + (ob ^ (((ob >> 9) & 1) << 5)); }
__host__ __device__ __forceinline__ void stage_rc(int b, int& R, int& C) { const int st = b / 1024, sb = b % 1024, swz = sb ^ (((sb >> 9) & 1) << 5); R = (st >> 1) * 16 + swz / 64; C = (st & 1) * 32 + (swz % 64) / 2; }
__host__ __device__ __forceinline__ int perm32(int rho) { const int n = rho >> 4, i = rho & 15; return 8 * (i >> 2) + 4 * n + (i & 3); }

struct Unit { int pm, pn; };
struct Gemm { const bf16_t* A; const bf16_t* Bt; int M, N, K; };

struct StaticOrder {
    int nM, nN, nwg, G, c;
    __host__ __device__ void init(int M, int N, int G_, int c_) { nM = M / BM; nN = N / BM; nwg = nM * nN; G = G_; c = c_; }
    __host__ __device__ bool next(int i, Unit& u) const {
        const long L = (long)i * G + c; if (L >= nwg) return false;
        int wgid = (int)L; { const int q = nwg / NXCD, r = nwg % NXCD, xcd = wgid % NXCD, off = wgid / NXCD; wgid = (xcd < r ? xcd * (q + 1) : r * (q + 1) + (xcd - r) * q) + off; }
        const int nig = WGM * nN, gid = wgid / nig, fm = gid * WGM, gsz = (nM - fm) < WGM ? (nM - fm) : WGM;
        u.pm = fm + ((wgid % nig) % gsz); u.pn = (wgid % nig) / gsz; return true;
    }
    __device__ __forceinline__ void a_ready(const Unit&) const {}
    __device__ __forceinline__ void done(const Unit&) const {}
};

__device__ __forceinline__ unsigned cvt_pk_bf16(float lo, float hi) { unsigned r; asm volatile("v_cvt_pk_bf16_f32 %0, %1, %2" : "=v"(r) : "v"(lo), "v"(hi)); return r; }
typedef float f32x2 __attribute__((ext_vector_type(2)));
__device__ __forceinline__ f32x2 gelu_pk(f32x2 v) {
    const f32x2 av = __builtin_elementwise_abs(v), d = av * 0.2316418882f + 1.0f;
    f32x2 t; t.x = __builtin_amdgcn_rcpf(d.x); t.y = __builtin_amdgcn_rcpf(d.y);
    f32x2 q = t * 0.5307027145f + (-0.7265760135f); q = q * t + 0.7107068705f; q = q * t + (-0.142248368f); q = q * t + 0.127414796f; q = q * t;
    const f32x2 s = (v * v) * (-0.72134752044f);
    f32x2 e; e.x = __builtin_amdgcn_exp2f(s.x); e.y = __builtin_amdgcn_exp2f(s.y);
    const f32x2 m = v * (q * e), r = v - m;
    f32x2 o; o.x = v.x < 0.f ? m.x : r.x; o.y = v.y < 0.f ? m.y : r.y; return o;
}

template <int ACT  > struct EpiBf16 {
    static constexpr bool PERM = true, AFTER_DRAIN = false; static_assert(ACT == 0 || ACT == 1, "EpiBf16: ACT is 0 (none) or 1 (gelu_pk)");
    bf16_t* O; int ldc; const float* bias; int split_cols; size_t split_stride; float scale0;
    __device__ __forceinline__ void operator()(const f32x4 (&acc)[2][2][4][2], const Unit& u, int wr, int wc, int fr, int fq) const {
        const int row0 = u.pm * BM + wr * 64 + fr; int colt = u.pn * BM; bf16_t* base = O;
        float sc = 1.f; if (split_cols) { const int t = colt / split_cols; base += (size_t)t * split_stride; colt -= t * split_cols; if (t == 0) sc = scale0; }
        const int col0 = colt + wc * 32 + 8 * fq, bcol0 = u.pn * BM + wc * 32 + 8 * fq;
        f32x4 bv[2][2];
#pragma unroll
        for (int bj = 0; bj < 2; ++bj)
#pragma unroll
            for (int n = 0; n < 2; ++n) bv[bj][n] = bias ? *(const f32x4*)(bias + bcol0 + bj * HALF + 4 * n) : (f32x4){0.f, 0.f, 0.f, 0.f};
#pragma unroll
        for (int ai = 0; ai < 2; ++ai)
#pragma unroll
            for (int m = 0; m < 4; ++m) { bf16_t* rowp = base + (size_t)(row0 + ai * HALF + m * 16) * ldc + col0;
#pragma unroll
                for (int bj = 0; bj < 2; ++bj) { f32x4 v0 = acc[ai][bj][m][0] + bv[bj][0], v1 = acc[ai][bj][m][1] + bv[bj][1];
                    if (ACT == 1) { f32x2 a = gelu_pk((f32x2){v0[0], v0[1]}), b = gelu_pk((f32x2){v0[2], v0[3]}), c = gelu_pk((f32x2){v1[0], v1[1]}), d = gelu_pk((f32x2){v1[2], v1[3]});
                        v0 = (f32x4){a.x, a.y, b.x, b.y}; v1 = (f32x4){c.x, c.y, d.x, d.y}; }
                    v0 = v0 * sc; v1 = v1 * sc; u32x4 w; w.x = cvt_pk_bf16(v0[0], v0[1]); w.y = cvt_pk_bf16(v0[2], v0[3]); w.z = cvt_pk_bf16(v1[0], v1[1]); w.w = cvt_pk_bf16(v1[2], v1[3]);
                    *(u32x4*)(rowp + bj * HALF) = w; } }
    }
};
template <class Epi, class Sched, bool ALIGN_EPI = false, bool SP2 = false, bool F8 = false>
__device__ __forceinline__ void gemm_phase(PG8_LAS unsigned char* lds, const Gemm g, const Sched& S, const Epi& E, int wave_id) {
    typedef int i32x4_t __attribute__((ext_vector_type(4))); typedef int i32x8_t __attribute__((ext_vector_type(8)));
    int tid; { int l_; asm volatile("v_mbcnt_lo_u32_b32 %0, -1, 0\n\tv_mbcnt_hi_u32_b32 %0, -1, %0" : "=v"(l_)); tid = wave_id * 64 + l_; }
    const int wid = __builtin_amdgcn_readfirstlane(tid >> 6), lane = tid & 63, wr = wid >> 2, wc = wid & 3, fr = lane & 15, fq = lane >> 4;
    const int K = g.K, nt = K / BK;
    unsigned voffA[2], voffB[2];
#pragma unroll
    for (int i = 0; i < 2; ++i) { int R, C; stage_rc(tid * 16 + i * 8192, R, C); const int Rb = Epi::PERM ? ((R & ~31) + perm32(R & 31)) : R;
        voffA[i] = (unsigned)(R * K + C) * 2u; voffB[i] = (unsigned)(Rb * K + C) * 2u; }
    const size_t kstep = (size_t)(BK * 2);
    const size_t hstep = (size_t)HALF * K * 2;
    const size_t tstep = 2 * hstep;
    const unsigned ldsw = (unsigned)wid * 1024u;
    const int aoff = lds_byte(wr * 64 + fr, fq * 8), boff = lds_byte(wc * 32 + fr, fq * 8);
#define PG8_SA(b, h) (((b) * 2 + (h)) * HTB)
#define PG8_SB(b, h) ((4 + (b) * 2 + (h)) * HTB)
#define PG8_STAGE(bufoff, gbase, voff) do { _Pragma("unroll") for (int _i = 0; _i < 2; ++_i) \
        __builtin_amdgcn_global_load_lds((const unsigned*)((const char*)(gbase) + (voff)[_i]), (PG8_LAS unsigned*)(lds + (bufoff) + ldsw + _i * 8192), 16, 0, 0); } while (0)
#define PG8_LDA(dst, b, h) do { if constexpr (F8) { _Pragma("unroll") for (int m = 0; m < 4; ++m) { const i32x4_t lo_ = *(const PG8_LAS i32x4_t*)(lds + PG8_SA(b, h) + aoff + m * 2048), hi_ = *(const PG8_LAS i32x4_t*)(lds + PG8_SA(b, h) + aoff + m * 2048 + 1024); dst##8[m] = __builtin_shufflevector(lo_, hi_, 0, 1, 2, 3, 4, 5, 6, 7); } } \
    else { _Pragma("unroll") for (int m = 0; m < 4; ++m) _Pragma("unroll") for (int k = 0; k < 2; ++k) dst[m][k] = *(const PG8_LAS bf16x8*)(lds + PG8_SA(b, h) + aoff + m * 2048 + k * 1024); } } while (0)
#define PG8_LDB(dst, b, h) do { if constexpr (F8) { _Pragma("unroll") for (int n = 0; n < 2; ++n) { const i32x4_t lo_ = *(const PG8_LAS i32x4_t*)(lds + PG8_SB(b, h) + boff + n * 2048), hi_ = *(const PG8_LAS i32x4_t*)(lds + PG8_SB(b, h) + boff + n * 2048 + 1024); dst##8[n] = __builtin_shufflevector(lo_, hi_, 0, 1, 2, 3, 4, 5, 6, 7); } } \
    else { _Pragma("unroll") for (int n = 0; n < 2; ++n) _Pragma("unroll") for (int k = 0; k < 2; ++k) dst[n][k] = *(const PG8_LAS bf16x8*)(lds + PG8_SB(b, h) + boff + n * 2048 + k * 1024); } } while (0)
#define PG8_MMA(ai, bj, At, Bt) do { __builtin_amdgcn_s_setprio(1); \
        if constexpr (F8) {   \
            _Pragma("unroll") for (int m = 0; m < 4; ++m) _Pragma("unroll") for (int n = 0; n < 2; ++n) \
                asm volatile("v_mfma_scale_f32_16x16x128_f8f6f4 %0, %1, %2, %0, %3, %4 op_sel_hi:[0,0,0]" : "+v"(acc[ai][bj][m][n]) : "v"(Bt##8[n]), "v"(At##8[m]), "v"(f8sa), "v"(f8sb));   \
        } else { _Pragma("unroll") for (int m = 0; m < 4; ++m) _Pragma("unroll") for (int n = 0; n < 2; ++n) _Pragma("unroll") for (int k = 0; k < 2; ++k) \
        acc[ai][bj][m][n] = __builtin_amdgcn_mfma_f32_16x16x32_bf16(Bt[n][k], At[m][k], acc[ai][bj][m][n], 0, 0, 0); } __builtin_amdgcn_s_setprio(0); } while (0)
#define PG8_WAIT_V(n) asm volatile("s_waitcnt vmcnt(" #n ")" ::: "memory")
#define PG8_WAIT_L(n) asm volatile("s_waitcnt lgkmcnt(" #n ")" ::: "memory")
#define PG8_BAR __builtin_amdgcn_s_barrier()
#define PG8_SCHED __builtin_amdgcn_sched_barrier(0)
    Unit cur, nxt; int ui = 0;
    if (!S.next(0, cur)) return;
    f32x4 acc[2][2][4][2];
#pragma unroll
    for (int a = 0; a < 2; ++a)
#pragma unroll
        for (int b = 0; b < 2; ++b)
#pragma unroll
            for (int m = 0; m < 4; ++m)
#pragma unroll
                for (int n = 0; n < 2; ++n) acc[a][b][m][n] = (f32x4){0.f, 0.f, 0.f, 0.f};
    bf16x8 At[4][2], B0[2][2], B1[2][2]; i32x8_t At8[4], B08[2], B18[2];
    int f8sa = 121, f8sb = 127; asm volatile("" : "+v"(f8sa), "+v"(f8sb));
    const char* cA = (const char*)g.A + (size_t)cur.pm * tstep; const char* cB = (const char*)g.Bt + (size_t)cur.pn * tstep;
    S.a_ready(cur);
    if constexpr (SP2) {
        PG8_STAGE(PG8_SB(0, 0), cB, voffB); PG8_STAGE(PG8_SB(0, 1), cB + hstep, voffB); PG8_STAGE(PG8_SA(0, 0), cA, voffA); PG8_STAGE(PG8_SA(0, 1), cA + hstep, voffA);
        if (wr == 1) PG8_BAR;
        PG8_WAIT_V(2); PG8_BAR;
        PG8_STAGE(PG8_SB(1, 0), cB + kstep, voffB); PG8_STAGE(PG8_SA(1, 0), cA + kstep, voffA); PG8_STAGE(PG8_SB(1, 1), cB + hstep + kstep, voffB);
        PG8_WAIT_V(6); PG8_BAR;
    } else {
        PG8_STAGE(PG8_SB(0, 0), cB, voffB); PG8_STAGE(PG8_SA(0, 0), cA, voffA); PG8_STAGE(PG8_SB(0, 1), cB + hstep, voffB); PG8_STAGE(PG8_SA(0, 1), cA + hstep, voffA);
        if (wr == 1) PG8_BAR;
        PG8_WAIT_V(4); PG8_BAR;
        PG8_STAGE(PG8_SB(1, 0), cB + kstep, voffB); PG8_STAGE(PG8_SA(1, 0), cA + kstep, voffA); PG8_STAGE(PG8_SB(1, 1), cB + hstep + kstep, voffB);
        PG8_WAIT_V(6); PG8_BAR;
    }
    for (;;) {
        const bool has_next = S.next(ui + 1, nxt);
        const char* nA = has_next ? (const char*)g.A + (size_t)nxt.pm * tstep : cA; const char* nB = has_next ? (const char*)g.Bt + (size_t)nxt.pn * tstep : cB;
        for (int t = 0; t < nt; t += 2) {
            const bool last = (t == nt - 2);
            const char* a1 = cA + (size_t)(t + 1) * kstep;
            const char* a2 = last ? nA : cA + (size_t)(t + 2) * kstep; const char* b2 = last ? nB : cB + (size_t)(t + 2) * kstep;
            const char* a3 = a2 + kstep; const char* b3 = b2 + kstep;
            if (last && has_next) S.a_ready(nxt);
            if constexpr (SP2) {
            PG8_LDB(B0, 0, 0); PG8_LDB(B1, 0, 1); PG8_SCHED; PG8_LDA(At, 0, 0); PG8_STAGE(PG8_SA(1, 1), a1 + hstep, voffA);
            PG8_WAIT_V(8); PG8_WAIT_L(0); PG8_BAR; PG8_MMA(0, 0, At, B0); PG8_MMA(0, 1, At, B1); PG8_BAR; PG8_SCHED;
            PG8_LDA(At, 0, 1); PG8_STAGE(PG8_SB(0, 0), b2, voffB); PG8_STAGE(PG8_SB(0, 1), b2 + hstep, voffB); PG8_STAGE(PG8_SA(0, 0), a2, voffA);
            PG8_WAIT_V(8); PG8_WAIT_L(0); PG8_BAR; PG8_MMA(1, 0, At, B0); PG8_MMA(1, 1, At, B1); PG8_BAR; PG8_SCHED;
            PG8_LDB(B0, 1, 0); PG8_LDB(B1, 1, 1); PG8_SCHED; PG8_LDA(At, 1, 0); PG8_STAGE(PG8_SA(0, 1), a2 + hstep, voffA);
            PG8_WAIT_V(8); PG8_WAIT_L(0); PG8_BAR; PG8_MMA(0, 0, At, B0); PG8_MMA(0, 1, At, B1); PG8_BAR; PG8_SCHED;
            PG8_LDA(At, 1, 1); PG8_STAGE(PG8_SB(1, 0), b3, voffB); PG8_STAGE(PG8_SB(1, 1), b3 + hstep, voffB); PG8_STAGE(PG8_SA(1, 0), a3, voffA);
            PG8_WAIT_V(8); PG8_WAIT_L(0); PG8_BAR; PG8_MMA(1, 0, At, B0); PG8_MMA(1, 1, At, B1); PG8_BAR; PG8_SCHED;
            } else {
            PG8_LDB(B0, 0, 0); PG8_SCHED; PG8_LDA(At, 0, 0); PG8_STAGE(PG8_SA(1, 1), a1 + hstep, voffA);
            PG8_WAIT_L(8); PG8_BAR; PG8_WAIT_L(0); PG8_MMA(0, 0, At, B0); PG8_BAR; PG8_SCHED;
            PG8_LDB(B1, 0, 1); PG8_STAGE(PG8_SB(0, 0), b2, voffB);
            PG8_BAR; PG8_WAIT_L(0); PG8_MMA(0, 1, At, B1); PG8_BAR;
            PG8_LDA(At, 0, 1); PG8_STAGE(PG8_SA(0, 0), a2, voffA);
            PG8_BAR; PG8_WAIT_L(0); PG8_MMA(1, 0, At, B0); PG8_BAR; PG8_SCHED;
            PG8_STAGE(PG8_SB(0, 1), b2 + hstep, voffB);
            PG8_WAIT_V(6); PG8_BAR; PG8_MMA(1, 1, At, B1); PG8_BAR;
            PG8_LDB(B0, 1, 0); PG8_SCHED; PG8_LDA(At, 1, 0); PG8_STAGE(PG8_SA(0, 1), a2 + hstep, voffA);
            PG8_WAIT_L(8); PG8_BAR; PG8_WAIT_L(0); PG8_MMA(0, 0, At, B0); PG8_BAR; PG8_SCHED;
            PG8_LDB(B1, 1, 1); PG8_STAGE(PG8_SB(1, 0), b3, voffB);
            PG8_BAR; PG8_WAIT_L(0); PG8_MMA(0, 1, At, B1); PG8_BAR;
            PG8_LDA(At, 1, 1); PG8_STAGE(PG8_SA(1, 0), a3, voffA);
            PG8_BAR; PG8_WAIT_L(0); PG8_MMA(1, 0, At, B0); PG8_BAR; PG8_SCHED;
            PG8_STAGE(PG8_SB(1, 1), b3 + hstep, voffB);
            PG8_WAIT_V(6); PG8_BAR; PG8_MMA(1, 1, At, B1); PG8_BAR;
            }
        }
        if constexpr (ALIGN_EPI) { if (wr == 0) PG8_BAR; }
        if constexpr (F8) asm volatile("s_nop 15\n\ts_nop 15" ::: "memory");
        if constexpr (!Epi::AFTER_DRAIN) { E(acc, cur, wr, wc, fr, fq); S.done(cur); }
        if (!has_next) break;
#pragma unroll
        for (int a = 0; a < 2; ++a)
#pragma unroll
            for (int b = 0; b < 2; ++b)
#pragma unroll
                for (int m = 0; m < 4; ++m)
#pragma unroll
                    for (int n = 0; n < 2; ++n) acc[a][b][m][n] = (f32x4){0.f, 0.f, 0.f, 0.f};
        cur = nxt; cA = nA; cB = nB; ++ui;
        if constexpr (ALIGN_EPI) { if (wr == 1) PG8_BAR; }
    }
    PG8_WAIT_V(0);
    if constexpr (!ALIGN_EPI) { if (wr == 0) PG8_BAR; }
    PG8_BAR;
    if constexpr (Epi::AFTER_DRAIN) { E.fused(acc, cur, wr, wc, fr, fq, lds, wid, lane); S.done(cur); }
#undef PG8_SA
#undef PG8_SB
#undef PG8_STAGE
#undef PG8_LDA
#undef PG8_LDB
#undef PG8_MMA
#undef PG8_WAIT_V
#undef PG8_WAIT_L
#undef PG8_BAR
#undef PG8_SCHED
}
}
namespace att {
using bf16 = unsigned short;
using bf16x8 = __attribute__((ext_vector_type(8))) short;
using s16x4  = __attribute__((ext_vector_type(4))) short;
using f32x16 = __attribute__((ext_vector_type(16))) float;
using u32x4  = __attribute__((ext_vector_type(4))) unsigned;
constexpr int NW = 8, QBLK = 32, KVBLK = 64;
constexpr int LDX = 4608;
constexpr int SHM_V = 16384, SHM_K = 16384, SHM_ATTN = 2 * SHM_V + 2 * SHM_K + NW * 64 * 4;
#define ATT_SBAR() __builtin_amdgcn_sched_barrier(0)
#define ATT_THR 8.f
__device__ __forceinline__ int crow(int r, int hi) { return (r & 3) + 8 * (r >> 2) + 4 * hi; }
__device__ __forceinline__ unsigned cvtpk(float lo, float hi) { unsigned r; asm volatile("v_cvt_pk_bf16_f32 %0, %1, %2" : "=v"(r) : "v"(lo), "v"(hi)); return r; }
template <int DQK> __device__ __forceinline__ int koff(int row, int colB) { return DQK == 128 ? row * 256 + (colB ^ ((row & 7) << 4)) : row * 128 + (colB ^ ((row & 7) << 4)); }

template <int DQK, bool NOMAX>
__device__ __forceinline__ void partialSM(f32x16& p0, f32x16& p1, float& m_reg, float& mn, float& alpha) {
  if constexpr (NOMAX) { mn = 0.f; alpha = 1.f;
#pragma unroll
    for (int r = 0; r < 16; ++r) p0[r] = __builtin_amdgcn_exp2f(p0[r]);
    return; }
  float pmax = p0[0];
#pragma unroll
  for (int r = 1; r < 16; ++r) pmax = fmaxf(pmax, p0[r]);
#pragma unroll
  for (int r = 0; r < 16; ++r) pmax = fmaxf(pmax, p1[r]);
  { auto rr = __builtin_amdgcn_permlane32_swap(__float_as_uint(pmax), __float_as_uint(pmax), false, false);
    pmax = fmaxf(__uint_as_float(rr[0]), __uint_as_float(rr[1])); }
  if (__builtin_expect(__all(pmax - m_reg <= ATT_THR), 1)) { mn = m_reg; alpha = 1.f; }
  else { mn = fmaxf(m_reg, pmax); alpha = __builtin_amdgcn_exp2f(m_reg - mn); m_reg = mn; }
#pragma unroll
  for (int r = 0; r < 16; ++r) p0[r] = p0[r] - mn;
#pragma unroll
  for (int r = 0; r < 16; ++r) p1[r] = p1[r] - mn;
#pragma unroll
  for (int r = 0; r < 16; ++r) p0[r] = __builtin_amdgcn_exp2f(p0[r]);
}
#define ATT_PK4(P, BASE, OUT) do { unsigned a0 = cvtpk(P[BASE + 0], P[BASE + 1]), a1 = cvtpk(P[BASE + 2], P[BASE + 3]);   \
    unsigned b0 = cvtpk(P[BASE + 4], P[BASE + 5]), b1 = cvtpk(P[BASE + 6], P[BASE + 7]);                              \
    auto r0 = __builtin_amdgcn_permlane32_swap(a0, b0, false, false); auto r1 = __builtin_amdgcn_permlane32_swap(a1, b1, false, false); \
    u32x4 w = {r0[0], r1[0], r0[1], r1[1]}; OUT = *reinterpret_cast<bf16x8*>(&w); } while (0)
__device__ __forceinline__ void finishSM(f32x16& p0, f32x16& p1, float alpha, float& l_reg, bf16x8& pa0, bf16x8& pa1, bf16x8& pa2, bf16x8& pa3) {
#pragma unroll
  for (int r = 0; r < 16; ++r) p1[r] = __builtin_amdgcn_exp2f(p1[r]);
  float ps = 0;
#pragma unroll
  for (int r = 0; r < 16; ++r) ps += p0[r];
#pragma unroll
  for (int r = 0; r < 16; ++r) ps += p1[r];
  { auto rr = __builtin_amdgcn_permlane32_swap(__float_as_uint(ps), __float_as_uint(ps), false, false);
    ps = __uint_as_float(rr[0]) + __uint_as_float(rr[1]); }
  l_reg = l_reg * alpha + ps;
  ATT_PK4(p0, 0, pa0); ATT_PK4(p0, 8, pa1); ATT_PK4(p1, 0, pa2); ATT_PK4(p1, 8, pa3);
}
template <int DQK>
__device__ __forceinline__ void qkt(f32x16& p0, f32x16& p1, const char* Ks, const bf16x8* qr, int r32, int hi) {
  p0 = f32x16{}; p1 = f32x16{};
#pragma unroll
  for (int d0 = 0; d0 < DQK / 16; ++d0) { int cb = (d0 * 16 + hi * 8) * 2;
    bf16x8 b0 = *reinterpret_cast<const bf16x8*>(Ks + koff<DQK>(r32, cb));
    bf16x8 b1 = *reinterpret_cast<const bf16x8*>(Ks + koff<DQK>(32 + r32, cb));
    p0 = __builtin_amdgcn_mfma_f32_32x32x16_bf16(b0, qr[d0], p0, 0, 0, 0);
    p1 = __builtin_amdgcn_mfma_f32_32x32x16_bf16(b1, qr[d0], p1, 0, 0, 0); }
}
__device__ __forceinline__ int v_st(int k, int c) { const int kk = (k & ~0xC) | ((k & 4) << 1) | ((k & 8) >> 1); return ((kk >> 3) * 4 + (c >> 5)) * 512 + ((kk & 7) * 32 + (c & 31)) * 2; }
__device__ __forceinline__ int v_rd_base(int lane) { return ((lane & 3) << 3) | (((lane >> 2) & 3) << 6) | (((lane >> 4) & 1) << 5) | (((lane >> 5) & 1) << 8); }
constexpr int v_rd_off(int d0, int ks, int half) { return d0 * 512 + ks * 4096 + half * 2048; }
template <int OFF> __device__ __forceinline__ s16x4 tr_read(int vb) {
  s16x4 r; asm volatile("ds_read_b64_tr_b16 %0, %1 offset:%2" : "=&v"(r) : "v"(vb), "i"(OFF) : "memory"); return r;
}
template <int D0> __device__ __forceinline__ void pv_one(f32x16& od, int vb, bf16x8 pa0, bf16x8 pa1, bf16x8 pa2, bf16x8 pa3) {
  const s16x4 l0 = tr_read<v_rd_off(D0, 0, 0)>(vb), h0 = tr_read<v_rd_off(D0, 0, 1)>(vb), l1 = tr_read<v_rd_off(D0, 1, 0)>(vb), h1 = tr_read<v_rd_off(D0, 1, 1)>(vb);
  const s16x4 l2 = tr_read<v_rd_off(D0, 2, 0)>(vb), h2 = tr_read<v_rd_off(D0, 2, 1)>(vb), l3 = tr_read<v_rd_off(D0, 3, 0)>(vb), h3 = tr_read<v_rd_off(D0, 3, 1)>(vb);
  asm volatile("s_waitcnt lgkmcnt(0)" ::: "memory"); ATT_SBAR();
#define ATT_PK(L, H) (bf16x8){L[0], L[1], L[2], L[3], H[0], H[1], H[2], H[3]}
  od = __builtin_amdgcn_mfma_f32_32x32x16_bf16(pa0, ATT_PK(l0, h0), od, 0, 0, 0);
  od = __builtin_amdgcn_mfma_f32_32x32x16_bf16(pa1, ATT_PK(l1, h1), od, 0, 0, 0);
  od = __builtin_amdgcn_mfma_f32_32x32x16_bf16(pa2, ATT_PK(l2, h2), od, 0, 0, 0);
  od = __builtin_amdgcn_mfma_f32_32x32x16_bf16(pa3, ATT_PK(l3, h3), od, 0, 0, 0);
#undef ATT_PK
}
__device__ __forceinline__ void pv_d0(f32x16* o, int vb, bf16x8 pa0, bf16x8 pa1, bf16x8 pa2, bf16x8 pa3) {
  pv_one<0>(o[0], vb, pa0, pa1, pa2, pa3); pv_one<1>(o[1], vb, pa0, pa1, pa2, pa3); pv_one<2>(o[2], vb, pa0, pa1, pa2, pa3); pv_one<3>(o[3], vb, pa0, pa1, pa2, pa3);
}

template <int DQK, bool NOMAX = false>
__device__ __forceinline__ void attn_body(const bf16* __restrict__ Qb, const bf16* __restrict__ Kh, const bf16* __restrict__ Vh, int seq, char* lds,
                                          f32x16 (&o)[4], float (&rli)[16], int tid_in) {
  int tid = tid_in; asm volatile("" : "+v"(tid));
  const int wid = tid >> 6, lane = tid & 63, r32 = lane & 31, hi = lane >> 5;
  char* V_lds = lds; char* K_lds = lds + 2 * SHM_V;
  float* ws = (float*)(lds + 2 * SHM_V + 2 * SHM_K) + wid * 64; float* li_l = ws; float* al_l = ws + 32;
  float m_reg = -1e30f, l_reg = 0; bf16x8 qr[DQK / 16];
#pragma unroll
  for (int d = 0; d < 4; ++d) o[d] = f32x16{};
  const bf16* Qw = Qb + (long)(wid * QBLK + r32) * LDX + hi * 8;
#pragma unroll
  for (int d0 = 0; d0 < DQK / 16; ++d0) qr[d0] = *reinterpret_cast<const bf16x8*>(Qw + d0 * 16);
  const int sr = tid >> 4, sc = (tid & 15) * 8, vst0 = v_st(sr, sc), vst1 = v_st(32 + sr, sc);
  const int kr = (DQK == 128) ? sr : (tid >> 3), kc = (DQK == 128) ? sc : (tid & 7) * 8;
  const int vb0 = (int)(uintptr_t)V_lds + v_rd_base(lane);
  const unsigned voff0 = (unsigned)(sr * LDX + sc) * 2u, voff1 = voff0 + 32u * LDX * 2u, koff0 = (unsigned)(kr * LDX + kc) * 2u, koff1 = koff0 + 32u * LDX * 2u;
  struct { bf16x8 vs0, vs1, ks0, ks1; } sr_[2];
#define SLOAD(i, k0) do { const char* vbp = (const char*)(Vh + (long)(k0) * LDX); const char* kbp = (const char*)(Kh + (long)(k0) * LDX); \
    sr_[i].vs0 = *reinterpret_cast<const bf16x8*>(vbp + voff0); sr_[i].vs1 = *reinterpret_cast<const bf16x8*>(vbp + voff1); \
    sr_[i].ks0 = *reinterpret_cast<const bf16x8*>(kbp + koff0); if (DQK == 128) sr_[i].ks1 = *reinterpret_cast<const bf16x8*>(kbp + koff1); } while (0)
#define SWRITE(b, i) do { *(bf16x8*)(V_lds + (b) * SHM_V + vst0) = sr_[i].vs0; *(bf16x8*)(V_lds + (b) * SHM_V + vst1) = sr_[i].vs1;  \
    *(bf16x8*)(K_lds + (b) * SHM_K + koff<DQK>(kr, kc * 2)) = sr_[i].ks0; if (DQK == 128) *(bf16x8*)(K_lds + (b) * SHM_K + koff<DQK>(32 + kr, kc * 2)) = sr_[i].ks1; } while (0)
#define SWAIT() do { if (DQK == 128) asm volatile("s_waitcnt vmcnt(4)" ::: "memory"); else asm volatile("s_waitcnt vmcnt(3)" ::: "memory"); } while (0)
#define RESC(a) do { if (!NOMAX && __any((a) < 1.f)) { if (hi == 0) al_l[r32] = (a); asm volatile("s_waitcnt lgkmcnt(0)" ::: "memory"); \
    _Pragma("unroll") for (int d = 0; d < 4; ++d) _Pragma("unroll") for (int r = 0; r < 16; ++r) o[d][r] *= al_l[crow(r, hi)]; } } while (0)
  f32x16 pA0, pA1, pB0, pB1; float mnA, mnB, alA, alB; bf16x8 pa0, pa1, pa2, pa3; const int NT = seq / KVBLK;
  constexpr int SE = 0, SO = 1;
  SLOAD(SE, 0); asm volatile("s_waitcnt vmcnt(0)" ::: "memory"); SWRITE(0, SE); __syncthreads();
  qkt<DQK>(pA0, pA1, K_lds, qr, r32, hi); partialSM<DQK, NOMAX>(pA0, pA1, m_reg, mnA, alA);
  SLOAD(SO, KVBLK); if (2 < NT) SLOAD(SE, 2 * KVBLK);
  if (2 < NT) SWAIT(); else asm volatile("s_waitcnt vmcnt(0)" ::: "memory");
  SWRITE(1, SO); __syncthreads();
  for (int j = 1; j + 1 < NT; j += 2) {
    ATT_SBAR(); qkt<DQK>(pB0, pB1, K_lds + SHM_K, qr, r32, hi);
    finishSM(pA0, pA1, alA, l_reg, pa0, pa1, pa2, pa3); ATT_SBAR();
    SLOAD(SO, (j + 2) * KVBLK); ATT_SBAR();
    pv_d0(o, vb0, pa0, pa1, pa2, pa3); partialSM<DQK, NOMAX>(pB0, pB1, m_reg, mnB, alB);
    __syncthreads(); SWAIT(); SWRITE(0, SE);
    RESC(alB); __syncthreads();
    ATT_SBAR(); qkt<DQK>(pA0, pA1, K_lds, qr, r32, hi);
    finishSM(pB0, pB1, alB, l_reg, pa0, pa1, pa2, pa3); ATT_SBAR();
    if (j + 3 < NT) SLOAD(SE, (j + 3) * KVBLK); ATT_SBAR();
    pv_d0(o, vb0 + SHM_V, pa0, pa1, pa2, pa3); partialSM<DQK, NOMAX>(pA0, pA1, m_reg, mnA, alA);
    __syncthreads(); if (j + 3 < NT) SWAIT(); else asm volatile("s_waitcnt vmcnt(0)" ::: "memory");
    SWRITE(1, SO);
    RESC(alA); __syncthreads();
  }
  ATT_SBAR(); qkt<DQK>(pB0, pB1, K_lds + SHM_K, qr, r32, hi);
  finishSM(pA0, pA1, alA, l_reg, pa0, pa1, pa2, pa3); ATT_SBAR();
  pv_d0(o, vb0, pa0, pa1, pa2, pa3); partialSM<DQK, NOMAX>(pB0, pB1, m_reg, mnB, alB);
  __syncthreads(); RESC(alB);
  finishSM(pB0, pB1, alB, l_reg, pa0, pa1, pa2, pa3); ATT_SBAR();
  pv_d0(o, vb0 + SHM_V, pa0, pa1, pa2, pa3);
  if (hi == 0) li_l[r32] = l_reg; asm volatile("s_waitcnt lgkmcnt(0)" ::: "memory");
#pragma unroll
  for (int r = 0; r < 16; ++r) rli[r] = __builtin_amdgcn_rcpf(li_l[crow(r, hi)]);
#undef SLOAD
#undef SWRITE
#undef SWAIT
#undef RESC
}
}
constexpr int DM = 2048, NB = 8, SEQL = 2048, CTXL = 256, TPB = SEQL + CTXL  , MROWS = NB * TPB  ;
constexpr int INC = 4608, QC = 2304;
constexpr int DQ_OFF = 0, GQ_OFF = 512, RQ_OFF = 1536, RG_OFF = 1792;
constexpr int DK_OFF = QC + 0, DV_OFF = QC + 512, GK_OFF = QC + 1024, GV_OFF = QC + 1280, RK_OFF = QC + 1536, RV_OFF = QC + 1792;
constexpr int NEXP = 16384;
constexpr float NEPS = 1e-6f;
constexpr float W8_SCALE = 64.f;
constexpr float GQA8_SCALE = 16.f;
constexpr int NWAVES = 8, NTHR = 512;
constexpr int NCHUNK = 18;

#ifndef DBG_MASK
#define DBG_MASK 0x3F
#endif
constexpr unsigned DBG = DBG_MASK;

constexpr size_t MiB = 1u << 20;
constexpr size_t WS_CTL = 0, CTL_ZERO_BYTES = 1 * MiB;
constexpr size_t WS_MOD = 1 * MiB;
constexpr size_t WS_SCAL = WS_MOD + (size_t)2 * 9 * 12288 * 4;
constexpr size_t WS_GAINS = WS_SCAL + 1024;
constexpr size_t WS_SUBK = 2 * MiB;
constexpr size_t WS_RST = 4 * MiB;
constexpr size_t WS_DSC = 40 * MiB;
constexpr size_t WS_PIDX = 76 * MiB, WS_PGATE = 85 * MiB;
constexpr size_t WS_ROPE = 94 * MiB;
constexpr size_t WS_WIN = 96 * MiB, WS_WOUT = 132 * MiB, WS_WPQ = 148 * MiB;
constexpr size_t WS_U8 = 164 * MiB, WS_V8 = 228 * MiB;
constexpr size_t WS_US = 3 * MiB, WS_VS = WS_US + 131072, WS_HS = WS_VS + 131072, WS_HSUM = WS_HS + 131072;
constexpr size_t WS_H8 = 292 * MiB;
constexpr size_t WS_ACT = 330 * MiB;
constexpr size_t WS_HN = 420 * MiB, WS_CAT = 492 * MiB, WS_QKV = 564 * MiB, WS_XS = 726 * MiB, WS_END = 870 * MiB;

constexpr int RING_BYTES = 131072, LDSCTL_OFF = RING_BYTES, MISC_OFF = LDSCTL_OFF + 320, LDS_BYTES = 147456;
constexpr int CW_BAR = 4096;

#define GAS __attribute__((address_space(1)))
#define LAS __attribute__((address_space(3)))
typedef unsigned short bf16;
typedef unsigned v4u __attribute__((ext_vector_type(4)));
typedef float f32x4 __attribute__((ext_vector_type(4)));
typedef float f32x2 __attribute__((ext_vector_type(2)));
typedef short bf16x8 __attribute__((ext_vector_type(8)));
typedef __bf16 bf16x2_t __attribute__((ext_vector_type(2)));
#define LDS_WAIT() asm volatile("s_waitcnt lgkmcnt(0)" ::: "memory")
#define VM_WAIT() asm volatile("s_waitcnt vmcnt(0)" ::: "memory")
__device__ __forceinline__ unsigned pk2(float lo, float hi) { f32x2 v = {lo, hi}; bf16x2_t b = __builtin_convertvector(v, bf16x2_t); return __builtin_bit_cast(unsigned, b); }
__device__ __forceinline__ float bflo(unsigned w) { return __uint_as_float(w << 16); }
__device__ __forceinline__ float bfhi(unsigned w) { return __uint_as_float(w & 0xffff0000u); }
__device__ __forceinline__ float bf2f(bf16 h) { return __uint_as_float((unsigned)h << 16); }
__device__ __forceinline__ bf16 f2bf(float f) { return (bf16)(pk2(f, 0.f) & 0xffffu); }
__device__ __forceinline__ float wave_sum(float v) {
#pragma unroll
    for (int o = 1; o < 64; o <<= 1) v += __shfl_xor(v, o);
    return v;
}
__device__ __forceinline__ float half_sum32(float v) {
#pragma unroll
    for (int o = 1; o < 32; o <<= 1) v += __shfl_xor(v, o);
    return v;
}
__device__ __forceinline__ unsigned f8x4(float a, float b, float c, float d) { int w = __builtin_amdgcn_cvt_pk_fp8_f32(a, b, 0, false); w = __builtin_amdgcn_cvt_pk_fp8_f32(c, d, w, true); return (unsigned)w; }
__device__ __forceinline__ unsigned f8x1(float a) { return (unsigned)__builtin_amdgcn_cvt_pk_fp8_f32(a, a, 0, false) & 0xffu; }
__device__ __forceinline__ float f8tof(unsigned b) { return __builtin_amdgcn_cvt_f32_fp8((int)b, 0); }
__device__ __forceinline__ int lane_id_now() { int l_; asm volatile("v_mbcnt_lo_u32_b32 %0, -1, 0\n\tv_mbcnt_hi_u32_b32 %0, -1, %0" : "=v"(l_)); return l_; }
typedef __amdgpu_buffer_rsrc_t rsrc_t;
__device__ __forceinline__ rsrc_t mk_rsrc(const void* p, unsigned bytes) { return __builtin_amdgcn_make_buffer_rsrc((void*)p, 0, bytes, 0x00020000); }
#define BST16(val, rs, vo, so) __builtin_amdgcn_raw_buffer_store_b16((short)(val), rs, vo, so, 0)
#define BST8(val, rs, vo, so) __builtin_amdgcn_raw_buffer_store_b8((char)(val), rs, vo, so, 0)
#define BST32F(val, rs, vo, so) __builtin_amdgcn_raw_buffer_store_b32(__float_as_int(val), rs, vo, so, 0)
#define BLD32F(rs, vo, so) __int_as_float(__builtin_amdgcn_raw_buffer_load_b32(rs, vo, so, 0))
#define BLD16(rs, vo, so) ((unsigned short)__builtin_amdgcn_raw_buffer_load_b16(rs, vo, so, 0))
#define BLD128(rs, vo, so) __builtin_bit_cast(v4u, __builtin_amdgcn_raw_buffer_load_b128(rs, vo, so, 0))
__device__ __forceinline__ float siluf(float x) { return x / (1.f + __expf(-x)); }

#define XB_TMO      128
#define XB_XCNT(j)  (256  + 64 * (j))
#define XB_XSUB(j)  (1280 + 64 * (j))
#define XB_XGEN(j)  (2304 + 64 * (j))
#define XB_TOP      3328
#define XB_TOPGEN   3392
#define XCD_BAR_WORDS 3456
#define XB_SPIN_CAP (1u << 18)
__device__ __forceinline__ unsigned xb_ld(unsigned* p)              { return __hip_atomic_load(p, __ATOMIC_RELAXED, __HIP_MEMORY_SCOPE_AGENT); }
__device__ __forceinline__ unsigned xb_add(unsigned* p, unsigned v) { return __hip_atomic_fetch_add(p, v, __ATOMIC_RELAXED, __HIP_MEMORY_SCOPE_AGENT); }
__device__ __forceinline__ unsigned xb_xcc_id() { return (unsigned)__builtin_amdgcn_s_getreg((3 << 11) | 20) & 0xFu; }
#define XB_SPIN(cond, bar) do { unsigned _sp = 0; while (cond) { __builtin_amdgcn_s_sleep(1); \
    if ((++_sp & 255u) == 0u) { if (xb_ld(&(bar)[XB_TMO])) break; if (_sp > XB_SPIN_CAP) { atomicAdd(&(bar)[XB_TMO], 1u); break; } } } } while (0)
struct XcdBarrier { unsigned* bar; unsigned x; volatile LAS unsigned* st; int wave; };
__device__ __forceinline__ XcdBarrier xcd_barrier_post(unsigned* bar, volatile LAS unsigned* st) {
    XcdBarrier b; b.bar = bar; b.x = xb_xcc_id(); b.st = st; b.wave = __builtin_amdgcn_readfirstlane((int)threadIdx.x >> 6);
    if (threadIdx.x == 0) st[2] = xb_add(&bar[XB_XCNT(b.x)], 1u);
    return b;
}
__device__ __forceinline__ void xcd_barrier_complete(unsigned* bar, unsigned x, unsigned& nloc, unsigned& nx) {
    const unsigned G = gridDim.x * gridDim.y * gridDim.z;
    unsigned sum, cnt, mine, sp = 0u;
    for (;;) {
        sum = 0u; cnt = 0u; mine = 0u;
#pragma unroll
        for (unsigned j = 0; j < 16; ++j) { const unsigned c = xb_ld(&bar[XB_XCNT(j)]); sum += c; cnt += (c > 0u) ? 1u : 0u; mine = (j == x) ? c : mine; }
        if (sum == G) break;
        __builtin_amdgcn_s_sleep(1);
        if ((++sp & 255u) == 0u) { if (xb_ld(&bar[XB_TMO])) break; if (sp > XB_SPIN_CAP) { atomicAdd(&bar[XB_TMO], 1u); break; } }
    }
    nloc = mine > 0u ? mine : 1u; nx = cnt > 0u ? cnt : 1u;
}
__device__ __forceinline__ void xcd_barrier(const XcdBarrier& b) {
    asm volatile("s_waitcnt vmcnt(0)" ::: "memory");
    __syncthreads();
    if (b.wave == 0 && lane_id_now() == 0) {
        unsigned* bar = b.bar;
        unsigned bx = b.x; asm volatile("" : "+s"(bx));
        __builtin_amdgcn_s_waitcnt(0);
        unsigned nloc = b.st[0], nx = b.st[1];
        if (nloc == 0u) { xcd_barrier_complete(bar, bx, nloc, nx); b.st[0] = nloc; b.st[1] = nx; }
        const unsigned old = xb_add(&bar[XB_XSUB(bx)], 1u);
        const unsigned gen = old / nloc;
        if (old + 1u == (gen + 1u) * nloc) {
            __builtin_amdgcn_fence(__ATOMIC_RELEASE, "agent");
            asm volatile("s_waitcnt vmcnt(0)" ::: "memory");
            const unsigned og = xb_add(&bar[XB_TOP], 1u);
            const unsigned tg = og / nx;
            if (og + 1u == (tg + 1u) * nx) xb_add(&bar[XB_TOPGEN], 1u);
            else XB_SPIN(xb_ld(&bar[XB_TOPGEN]) == tg, bar);
            __builtin_amdgcn_fence(__ATOMIC_ACQUIRE, "agent");
            xb_add(&bar[XB_XGEN(bx)], 1u);
            asm volatile("s_waitcnt vmcnt(0)" ::: "memory");
        } else {
            XB_SPIN(xb_ld(&bar[XB_XGEN(bx)]) == gen, bar);
            __builtin_amdgcn_fence(__ATOMIC_ACQUIRE, "agent");
            asm volatile("s_waitcnt vmcnt(0)" ::: "memory");
        }
    }
    __syncthreads();
}

namespace pg8 {
struct SegOrder {
    int nM[2], nN[2], rk[2], c0[2], start1, total, G, c;
    __device__ void init(int G_, int c_, int rk0, int c00, int nN0, int rk1, int c01, int nN1) {
        G = G_; c = c_; rk[0] = rk0; rk[1] = rk1; c0[0] = c00; c0[1] = c01; nN[0] = nN0; nN[1] = nN1;
        nM[0] = rk0 == 0 ? 72 : (rk0 == 1 ? 64 : 8); nM[1] = rk1 == 0 ? 72 : (rk1 == 1 ? 64 : 8);
        start1 = nM[0] * nN[0]; total = start1 + nM[1] * nN[1];
    }
    __device__ bool next(int i, Unit& u) const {
        const long L = (long)i * G + c; if (L >= total) return false;
        const int s = L >= start1 ? 1 : 0; int wgid = (int)L - (s ? start1 : 0);
        const int nwg = nM[s] * nN[s];
        { const int q = nwg / NXCD, r = nwg % NXCD, xcd = wgid % NXCD, off = wgid / NXCD; wgid = (xcd < r ? xcd * (q + 1) : r * (q + 1) + (xcd - r) * q) + off; }
        const int nig = WGM * nN[s], gid = wgid / nig, fm = gid * WGM, gsz = (nM[s] - fm) < WGM ? (nM[s] - fm) : WGM;
        const int j = fm + ((wgid % nig) % gsz);
        u.pm = rk[s] == 0 ? j : (rk[s] == 1 ? (j / 8) * 9 + 1 + (j % 8) : 9 * j);
        u.pn = c0[s] + (wgid % nig) / gsz; return true;
    }
    __device__ __forceinline__ void a_ready(const Unit&) const {}
    __device__ __forceinline__ void done(const Unit&) const {}
};
struct EpiResid {
    static constexpr bool PERM = true, AFTER_DRAIN = false;
    const float* xlat; const float* xctx; bf16_t* XS; const float* gate; float dbgs;
    __device__ __forceinline__ void operator()(const f32x4 (&acc)[2][2][4][2], const Unit& u, int wr, int wc, int fr, int fq) const {
        asm volatile("" : "+v"(fr));
        const int b = u.pm / 9, tt = u.pm % 9;
        const float* g = gate + (size_t)(tt == 0 ? 8 : b) * 12288;
        const float* src = xlat ? (tt == 0 ? xctx + (size_t)(b * 256) * 2048 : xlat + (size_t)(b * 2048 + (tt - 1) * 256) * 2048) : nullptr;
        bf16_t* dst = XS + (size_t)u.pm * 256 * 2048;
        const int col0 = u.pn * BM + wc * 32 + 8 * fq;
        f32x4 gv[2][2];
#pragma unroll
        for (int bj = 0; bj < 2; ++bj)
#pragma unroll
            for (int n = 0; n < 2; ++n) gv[bj][n] = *(const f32x4*)(g + col0 + bj * HALF + 4 * n) * dbgs;
#define ER_STORE(ro_, col_, x0_, x1_, ai_, bj_, m_) do { const f32x4 v0 = (x0_) + gv[bj_][0] * acc[ai_][bj_][m_][0], v1 = (x1_) + gv[bj_][1] * acc[ai_][bj_][m_][1]; \
            u32x4 o; o.x = cvt_pk_bf16(v0[0], v0[1]); o.y = cvt_pk_bf16(v0[2], v0[3]); o.z = cvt_pk_bf16(v1[0], v1[1]); o.w = cvt_pk_bf16(v1[2], v1[3]); *(u32x4*)(dst + (ro_) + (col_)) = o; } while (0)
        if (src) {
#pragma unroll
            for (int ai = 0; ai < 2; ++ai)
#pragma unroll
                for (int mh = 0; mh < 2; ++mh) { f32x4 xa[2][2][2];
#pragma unroll
                    for (int mq = 0; mq < 2; ++mq) { const size_t ro = (size_t)(ai * HALF + wr * 64 + (2 * mh + mq) * 16 + fr) * 2048;
#pragma unroll
                        for (int bj = 0; bj < 2; ++bj) { const int col = col0 + bj * HALF; xa[mq][bj][0] = *(const f32x4*)(src + ro + col); xa[mq][bj][1] = *(const f32x4*)(src + ro + col + 4); } }
                    __builtin_amdgcn_sched_barrier(0);
#pragma unroll
                    for (int mq = 0; mq < 2; ++mq) { const size_t ro = (size_t)(ai * HALF + wr * 64 + (2 * mh + mq) * 16 + fr) * 2048;
#pragma unroll
                        for (int bj = 0; bj < 2; ++bj) ER_STORE(ro, col0 + bj * HALF, xa[mq][bj][0], xa[mq][bj][1], ai, bj, 2 * mh + mq); }
                    __builtin_amdgcn_sched_barrier(0); }
        } else {
#pragma unroll
            for (int ai = 0; ai < 2; ++ai) { u32x4 xw[4][2];
#pragma unroll
                for (int m = 0; m < 4; ++m) { const size_t ro = (size_t)(ai * HALF + wr * 64 + m * 16 + fr) * 2048;
#pragma unroll
                    for (int bj = 0; bj < 2; ++bj) xw[m][bj] = *(const u32x4*)(dst + ro + col0 + bj * HALF); }
                __builtin_amdgcn_sched_barrier(0);
#pragma unroll
                for (int m = 0; m < 4; ++m) { const size_t ro = (size_t)(ai * HALF + wr * 64 + m * 16 + fr) * 2048;
#pragma unroll
                    for (int bj = 0; bj < 2; ++bj) { const u32x4 w = xw[m][bj];
                        const f32x4 x0 = {__uint_as_float(w.x << 16), __uint_as_float(w.x & 0xffff0000u), __uint_as_float(w.y << 16), __uint_as_float(w.y & 0xffff0000u)};
                        const f32x4 x1 = {__uint_as_float(w.z << 16), __uint_as_float(w.z & 0xffff0000u), __uint_as_float(w.w << 16), __uint_as_float(w.w & 0xffff0000u)};
                        ER_STORE(ro, col0 + bj * HALF, x0, x1, ai, bj, m); } }
                __builtin_amdgcn_sched_barrier(0); }
        }
#undef ER_STORE
    }
};
struct EpiQKV {
    static constexpr bool PERM = true, AFTER_DRAIN = false;
    bf16_t* O; const float* gains; const float* rope; PG8_LAS float* P;
    __device__ __forceinline__ void operator()(const f32x4 (&acc)[2][2][4][2], const Unit& u, int wr, int wc, int fr, int fq) const {
        if (!gains) return;
        const int pn = u.pn;
        const int mode = (pn < 2 || pn == 9 || pn == 10) ? 1 : (((pn >= 2 && pn <= 5) || pn == 13) ? 2 : (pn == 15 ? 3 : 0));
        const int tt = u.pm % 9; const bool isctx = tt == 0;
        int fro = fr; asm volatile("" : "+v"(fro));
        PG8_LAS float* pb = P + (wr * 64 + fro) * 8;
        const float* gain = gains + (mode == 1 ? (pn < 2 ? 0 : 128) : (pn <= 5 ? 256 : 384));
        if (mode == 1 || mode == 2) {
#pragma unroll
            for (int ai = 0; ai < 2; ++ai)
#pragma unroll
                for (int m = 0; m < 4; ++m)
#pragma unroll
                    for (int bj = 0; bj < 2; ++bj) { const f32x4 a = acc[ai][bj][m][0], b = acc[ai][bj][m][1];
                        float s = (a[0] * a[0] + a[1] * a[1]) + (a[2] * a[2] + a[3] * a[3]) + (b[0] * b[0] + b[1] * b[1]) + (b[2] * b[2] + b[3] * b[3]);
                        s += __shfl_xor(s, 16); s += __shfl_xor(s, 32);
                        if (fq == 0) pb[(ai * HALF + m * 16) * 8 + bj * 4 + wc] = s; }
            asm volatile("s_waitcnt lgkmcnt(0)" ::: "memory"); __builtin_amdgcn_s_barrier(); asm volatile("" ::: "memory");
        }
        const int cw = wc * 32 + 8 * fq;
        f32x4 g0[2], g1[2];
#pragma unroll
        for (int bj = 0; bj < 2; ++bj) { const int cv = mode == 1 ? ((bj * HALF + cw) & 63) : ((bj * HALF + cw) & 127);
            if (mode == 1 || mode == 2) { g0[bj] = *(const f32x4*)(gain + cv); g1[bj] = *(const f32x4*)(gain + cv + 4); } else { g0[bj] = (f32x4){1.f, 1.f, 1.f, 1.f}; g1[bj] = g0[bj]; } }
        const float sc3 = mode == 3 ? 0.125f : (pn < 2 ? 0.125f * 1.4426950408889634f : (pn <= 5 ? 0.088388347648318440f * 1.4426950408889634f : 1.f));
        float fr4[2][4]; bool rc[2];
#pragma unroll
        for (int bj = 0; bj < 2; ++bj) { const int cv = mode == 1 ? ((bj * HALF + cw) & 63) : ((bj * HALF + cw) & 127); const int i0 = cv >> 1;
            rc[bj] = mode == 1 ? (i0 >= 16) : (i0 >= 32);
#pragma unroll
            for (int q = 0; q < 4; ++q) { const int i = i0 + q; fr4[bj][q] = mode == 1 ? exp2f(-(float)(2 * (i & 15)) * (13.287712379549449f / 32.f)) : exp2f(-(float)(2 * (i & 31)) * (13.287712379549449f / 64.f)); } }
#pragma unroll
        for (int ai = 0; ai < 2; ++ai)
#pragma unroll
            for (int m = 0; m < 4; ++m) { const int rr = ai * HALF + wr * 64 + m * 16 + fr;
                bf16_t* rowp = O + (size_t)(u.pm * BM + rr) * 4608 + pn * BM + cw;
                const int tok = (tt - 1) * 256 + rr;
                const float prow = (float)(tok >> 6) * 0.15915494309189535f, pcol = (float)(tok & 63) * 0.15915494309189535f;
#pragma unroll
                for (int bj = 0; bj < 2; ++bj) { f32x4 v0 = acc[ai][bj][m][0], v1 = acc[ai][bj][m][1];
                    if (mode == 1 || mode == 2) { const PG8_LAS float* pp = pb + (ai * HALF + m * 16) * 8 + bj * 4;
                        const float tot = mode == 1 ? pp[wc & 2] + pp[(wc & 2) + 1] : (pp[0] + pp[1]) + (pp[2] + pp[3]);
                        const float r = rsqrtf(tot * (mode == 1 ? 1.f / 64.f : 1.f / 128.f) + 1e-6f); v0 = v0 * r * g0[bj]; v1 = v1 * r * g1[bj];
                        if (!isctx) { const float pos = rc[bj] ? pcol : prow;
                            float c4[4], s4[4];
#pragma unroll
                            for (int q = 0; q < 4; ++q) { const float a = pos * fr4[bj][q]; s4[q] = __builtin_amdgcn_sinf(a); c4[q] = __builtin_amdgcn_cosf(a); }
                            const f32x4 w0 = {v0[0] * c4[0] - v0[1] * s4[0], v0[0] * s4[0] + v0[1] * c4[0], v0[2] * c4[1] - v0[3] * s4[1], v0[2] * s4[1] + v0[3] * c4[1]};
                            const f32x4 w1 = {v1[0] * c4[2] - v1[1] * s4[2], v1[0] * s4[2] + v1[1] * c4[2], v1[2] * c4[3] - v1[3] * s4[3], v1[2] * s4[3] + v1[3] * c4[3]};
                            v0 = w0; v1 = w1; } }
                    v0 = v0 * sc3; v1 = v1 * sc3;
                    u32x4 w; w.x = cvt_pk_bf16(v0[0], v0[1]); w.y = cvt_pk_bf16(v0[2], v0[3]); w.z = cvt_pk_bf16(v1[0], v1[1]); w.w = cvt_pk_bf16(v1[2], v1[3]);
                    *(u32x4*)(rowp + bj * HALF) = w; }
                asm volatile("" ::: "memory"); }
    }
};
__device__ __forceinline__ size_t qp_frag_index(int token, int col) {
    const int tg = token >> 5, n = token & 31, head = col >> 8, p = (col >> 7) & 1, ks = (col >> 4) & 7, hi = (col >> 3) & 1, j = col & 7;
    return ((((((size_t)tg * 8 + head) * 2 + p) * 8 + ks) * 2 + hi) * 32 + n) * 8 + j;
}
struct EpiQP {
    static constexpr bool PERM = true, AFTER_DRAIN = false;
    bf16_t* O;
    __device__ __forceinline__ void operator()(const f32x4 (&acc)[2][2][4][2], const Unit& u, int wr, int wc, int fr, int fq) const {
        const rsrc_t rs = mk_rsrc(O + ((size_t)(u.pm * 8 + wr * 2) * 65536 + (size_t)u.pn * 8192), 6u * 65536u * 2u + 65536u * 2u);
        const unsigned vo = (unsigned)((2 * wc + (fq >> 1)) * 512 + (fq & 1) * 256 + fr * 8) * 2u;
#pragma unroll
        for (int ai = 0; ai < 2; ++ai)
#pragma unroll
            for (int m = 0; m < 4; ++m)
#pragma unroll
                for (int bj = 0; bj < 2; ++bj) { const f32x4 v0 = acc[ai][bj][m][0], v1 = acc[ai][bj][m][1];
                    u32x4 w; w.x = cvt_pk_bf16(v0[0], v0[1]); w.y = cvt_pk_bf16(v0[2], v0[3]); w.z = cvt_pk_bf16(v1[0], v1[1]); w.w = cvt_pk_bf16(v1[2], v1[3]);
                    __builtin_amdgcn_raw_buffer_store_b128(w, rs, vo, ((ai * 4 + (m >> 1)) * 65536 + bj * 4096 + (m & 1) * 128) * 2, 0); }
    }
};
}
struct Args { const float* in[22]; float* out; unsigned char* ws; int ph_lo, ph_hi, li, pad; };
struct Frame { LAS unsigned char* lds; unsigned char* ldsg; int tid, lane, wave, vcu, G; int px, pnx, prank, pcnt; };
__device__ __forceinline__ Frame refresh(const Frame& F0) { Frame F = F0;
    int t = F0.wave * 64 + lane_id_now();
    asm volatile("" : "+v"(t)); F.tid = t; F.lane = t & 63; return F; }
#define IN_X 0
#define IN_C 1
#define IN_CTX 2
#define IN_CCTX 3
#define IN_N1G 4
#define IN_N2G 5
#define IN_WMOD 6
#define IN_BMOD 7
#define IN_WIN 8
#define IN_WOUT 9
#define IN_DQG 10
#define IN_DKG 11
#define IN_DLAM 12
#define IN_DOG 13
#define IN_GQG 14
#define IN_GKG 15
#define IN_RDEC 16
#define IN_ROG 17
#define IN_PWQ 18
#define IN_PSK 19
#define IN_PU 20
#define IN_PV 21

__device__ __forceinline__ void p0_transpose_item_bf16(const float* W, int K, int N, bf16* WT, LAS float* scr, int item, int lane) {
    const int nblk = N / 32, kb = item / nblk, nb = item % nblk, k0 = 64 * kb, n0 = 32 * nb;
#pragma unroll
    for (int i = 0; i < 32; ++i) { const int kk = 2 * i + (lane >> 5); scr[kk * 33 + (lane & 31)] = W[(size_t)(k0 + kk) * N + n0 + (lane & 31)]; }
    LDS_WAIT(); asm volatile("" ::: "memory");
    const int c = lane & 7;
#pragma unroll
    for (int j = 0; j < 4; ++j) { const int n = (lane >> 3) + 8 * j; const LAS float* s = scr + (8 * c) * 33 + n;
        v4u o; o.x = pk2(s[0 * 33], s[1 * 33]); o.y = pk2(s[2 * 33], s[3 * 33]); o.z = pk2(s[4 * 33], s[5 * 33]); o.w = pk2(s[6 * 33], s[7 * 33]);
        *(GAS v4u*)(WT + (size_t)(n0 + n) * K + k0 + 8 * c) = o; }
    LDS_WAIT(); asm volatile("" ::: "memory");
}
__device__ __forceinline__ void p0_transpose_item(const float* W, int K, int N, unsigned char* WT, LAS float* scr, int item, int lane, int klo, int khi, float kscale) {
    const int nblk = N / 32, kb = item / nblk, nb = item % nblk, k0 = 64 * kb, n0 = 32 * nb;
#pragma unroll
    for (int i = 0; i < 32; ++i) { const int kk = 2 * i + (lane >> 5); scr[kk * 33 + (lane & 31)] = W[(size_t)(k0 + kk) * N + n0 + (lane & 31)]; }
    LDS_WAIT(); asm volatile("" ::: "memory");
    const int c = lane & 3;
    const float sc = W8_SCALE * ((k0 >= klo && k0 < khi) ? kscale : 1.f);
#pragma unroll
    for (int j = 0; j < 2; ++j) { const int n = (lane >> 2) + 16 * j; const LAS float* s = scr + (16 * c) * 33 + n;
        v4u o; o.x = f8x4(s[0 * 33] * sc, s[1 * 33] * sc, s[2 * 33] * sc, s[3 * 33] * sc); o.y = f8x4(s[4 * 33] * sc, s[5 * 33] * sc, s[6 * 33] * sc, s[7 * 33] * sc);
        o.z = f8x4(s[8 * 33] * sc, s[9 * 33] * sc, s[10 * 33] * sc, s[11 * 33] * sc); o.w = f8x4(s[12 * 33] * sc, s[13 * 33] * sc, s[14 * 33] * sc, s[15 * 33] * sc);
        *(GAS v4u*)(WT + (size_t)(n0 + n) * K + k0 + 16 * c) = o; }
    LDS_WAIT(); asm volatile("" ::: "memory");
}
__device__ __forceinline__ void cvt8(const float* src, bf16* dst, size_t i8) {
    const f32x4 a = *(const f32x4*)(src + i8 * 8), b = *(const f32x4*)(src + i8 * 8 + 4);
    v4u o; o.x = pk2(a.x, a.y); o.y = pk2(a.z, a.w); o.z = pk2(b.x, b.y); o.w = pk2(b.z, b.w);
    *(v4u*)(dst + i8 * 8) = o;
}
__device__ __forceinline__ void quant_u_row(const Args& A, int lane, int rowid) {
    unsigned char* ws = A.ws;
    const float* src = A.in[IN_PU] + (size_t)rowid * 2048 + lane * 32;
    f32x4 v[8]; float ss = 0.f;
#pragma unroll
    for (int j = 0; j < 8; ++j) { v[j] = *(const f32x4*)(src + j * 4); ss += (v[j].x * v[j].x + v[j].y * v[j].y) + (v[j].z * v[j].z + v[j].w * v[j].w); }
    ss = wave_sum(ss);
    const float sc = ss > 0.f ? 0.5f * sqrtf(ss * (1.f / 2048.f)) : 1.f, inv = 1.f / sc;
    if (lane == 0) ((float*)(ws + WS_US))[rowid] = sc;
    v4u o;
#pragma unroll
    for (int q = 0; q < 4; ++q) { const f32x4 a = v[2 * q], b = v[2 * q + 1];
        unsigned w = __builtin_amdgcn_cvt_scalef32_pk_fp4_f32(0u, a.x * inv, a.y * inv, 1.f, 0); w = __builtin_amdgcn_cvt_scalef32_pk_fp4_f32(w, a.z * inv, a.w * inv, 1.f, 1);
        w = __builtin_amdgcn_cvt_scalef32_pk_fp4_f32(w, b.x * inv, b.y * inv, 1.f, 2); w = __builtin_amdgcn_cvt_scalef32_pk_fp4_f32(w, b.z * inv, b.w * inv, 1.f, 3);
        if (q == 0) o.x = w; else if (q == 1) o.y = w; else if (q == 2) o.z = w; else o.w = w; }
    *(v4u*)(ws + WS_U8 + (size_t)rowid * 1024 + lane * 16) = o;
}
__device__ __forceinline__ void quant_v_row(const Args& A, int lane, int rowid) {
    unsigned char* ws = A.ws;
    const float* src = A.in[IN_PV] + (size_t)rowid * 2048 + lane * 4;
    f32x4 v[8]; float ss = 0.f;
#pragma unroll
    for (int j = 0; j < 8; ++j) { v[j] = *(const f32x4*)(src + j * 256); ss += (v[j].x * v[j].x + v[j].y * v[j].y) + (v[j].z * v[j].z + v[j].w * v[j].w); }
    ss = wave_sum(ss);
    const float sc = ss > 0.f ? 0.5f * sqrtf(ss * (1.f / 2048.f)) : 1.f, inv = 1.f / sc;
    if (lane == 0) ((float*)(ws + WS_VS))[rowid] = sc;
    unsigned short* dst = (unsigned short*)(ws + WS_V8 + (size_t)rowid * 1024) + lane;
#pragma unroll
    for (int j = 0; j < 8; ++j) { unsigned w = __builtin_amdgcn_cvt_scalef32_pk_fp4_f32(0u, v[j].x * inv, v[j].y * inv, 1.f, 0); w = __builtin_amdgcn_cvt_scalef32_pk_fp4_f32(w, v[j].z * inv, v[j].w * inv, 1.f, 1);
        dst[j * 64] = (unsigned short)w; }
}
__device__ __forceinline__ void quant_fill(const Args& A, const Frame& F0, int j0, int j1, int idle_rank, int n_idle) {
    const Frame F = refresh(F0);
    for (int j = j0 + idle_rank * NWAVES + F.wave; j < j1; j += n_idle * NWAVES) { const int lay = j >> 15, jj = j & 32767;
        if (jj < NEXP) quant_u_row(A, F.lane, lay * NEXP + jj); else quant_v_row(A, F.lane, lay * NEXP + jj - NEXP); }
}
__device__ __forceinline__ void phase_prologue(const Args& A, const Frame& F0, int pmode = 0) {
    const Frame F = refresh(F0);
    unsigned char* ws = A.ws;
    for (int it = F.vcu; it < (pmode == 2 ? 0 : 192); it += F.G) {
        const int layer = it / 96, cg = it % 96;
        LAS float* S = (LAS float*)F.lds;
        for (int idx = F.tid; idx < 9 * 2048; idx += NTHR) { const int r = idx >> 11, k = idx & 2047; const float v = r < 8 ? A.in[IN_C][r * 2048 + k] : A.in[IN_CCTX][k]; S[idx] = siluf(v); }
        __syncthreads();
        const int cq = F.tid & 31, ks = F.tid >> 5;
        f32x4 acc[9];
#pragma unroll
        for (int r = 0; r < 9; ++r) acc[r] = (f32x4){0.f, 0.f, 0.f, 0.f};
        const float* Wp = A.in[IN_WMOD] + ((size_t)layer * 2048 + ks * 128) * 12288 + cg * 128 + cq * 4;
#pragma unroll 16
        for (int kk = 0; kk < 128; ++kk) { const f32x4 w = *(const f32x4*)(Wp + (size_t)kk * 12288); const int k = ks * 128 + kk;
#pragma unroll
            for (int r = 0; r < 9; ++r) acc[r] += S[r * 2048 + k] * w; }
        __syncthreads();
        LAS float* P = (LAS float*)F.lds;
#pragma unroll
        for (int r = 0; r < 9; ++r) *(LAS f32x4*)(P + (ks * 9 + r) * 128 + cq * 4) = acc[r];
        __syncthreads();
        for (int o = F.tid; o < 9 * 128; o += NTHR) { const int r = o >> 7, cc = o & 127; float s = A.in[IN_BMOD][layer * 12288 + cg * 128 + cc];
#pragma unroll
            for (int q = 0; q < 16; ++q) s += P[(q * 9 + r) * 128 + cc];
            ((float*)(ws + WS_MOD))[(size_t)(layer * 9 + r) * 12288 + cg * 128 + cc] = s; }
        __syncthreads();
    }
    if (F.vcu == F.G - 1 && F.wave == 0) {
#pragma unroll
        for (int l = 0; l < 2; ++l) { const int i = F.lane; const float* lp = A.in[IN_DLAM] + l * 256;
            const float s0 = wave_sum(lp[i] * lp[64 + i]), s1 = wave_sum(lp[128 + i] * lp[192 + i]);
            const float lam_init = 0.8f - 0.6f * expf(-0.3f * (float)l); float* sc = (float*)(ws + WS_SCAL) + l * 16;
            if (i < 8) { const float z = A.in[IN_RDEC][l * 8 + i]; sc[2 + i] = -log2f(1.f + expf(-z)); }
            float mdq = fabsf(A.in[IN_DQG][l * 64 + i]), mdk = fabsf(A.in[IN_DKG][l * 64 + i]);
            float mgq = fmaxf(fabsf(A.in[IN_GQG][l * 128 + i]), fabsf(A.in[IN_GQG][l * 128 + 64 + i])), mgk = fmaxf(fabsf(A.in[IN_GKG][l * 128 + i]), fabsf(A.in[IN_GKG][l * 128 + 64 + i]));
#pragma unroll
            for (int o = 1; o < 64; o <<= 1) { mdq = fmaxf(mdq, __shfl_xor(mdq, o)); mdk = fmaxf(mdk, __shfl_xor(mdk, o)); mgq = fmaxf(mgq, __shfl_xor(mgq, o)); mgk = fmaxf(mgk, __shfl_xor(mgk, o)); }
            const float bg = 1.05f * 128.f * mgq * mgk * 0.088388347648318440f * 1.4426950408889634f, bd = 1.05f * 64.f * mdq * mdk * 0.125f * 1.4426950408889634f;
            if (i == 0) { sc[0] = expf(s0) - expf(s1) + lam_init; sc[1] = lam_init; sc[10] = (bg < 40.f) ? 1.f : 0.f; sc[11] = (bd < 40.f) ? 1.f : 0.f; } } }
    if (F.vcu == F.G - 2 || (F.G < 2 && F.vcu == 0)) { for (int i = F.tid; i < 2 * 4 * 128; i += NTHR) { const int l = i >> 9, st = (i >> 7) & 3, c = i & 127; float v = 1.f;
        if (st == 0) { if (c < 64) v = A.in[IN_DQG][l * 64 + c]; } else if (st == 1) { if (c < 64) v = A.in[IN_DKG][l * 64 + c]; } else if (st == 2) v = A.in[IN_GQG][l * 128 + c]; else v = A.in[IN_GKG][l * 128 + c];
        ((float*)(ws + WS_GAINS))[i] = v; } }
    { LAS float* scr = (LAS float*)(F.lds + F.wave * 16384);
      const int gw = F.vcu * NWAVES + F.wave, NGW = F.G * NWAVES;
      constexpr int I_IN = 32 * 144, I_O = 32 * 64, PER = I_IN + 2 * I_O;
      for (int it = gw; it < (pmode == 1 ? 0 : 2 * PER); it += NGW) { const int l = it / PER; int r = it % PER;
          if (r < I_IN) { p0_transpose_item(A.in[IN_WIN] + (size_t)l * 2048 * 4608, 2048, 4608, ws + WS_WIN + (size_t)l * 4608 * 2048, scr, r, F.lane, 0, 0, 1.f); continue; } r -= I_IN;
          if (r < I_O) { p0_transpose_item(A.in[IN_WOUT] + (size_t)l * 2048 * 2048, 2048, 2048, ws + WS_WOUT + (size_t)l * 2048 * 2048, scr, r, F.lane, 512, 1536, 1.f / GQA8_SCALE); continue; } r -= I_O;
          p0_transpose_item_bf16(A.in[IN_PWQ] + (size_t)l * 2048 * 2048, 2048, 2048, (bf16*)(ws + WS_WPQ) + (size_t)l * 2048 * 2048, scr, r, F.lane); } }
    { const size_t gt = (size_t)F.vcu * NTHR + F.tid, GT = (size_t)F.G * NTHR;
      constexpr size_t NS8 = (size_t)2 * 8 * 2 * 128 * 128 / 8;
      for (size_t i = gt; i < NS8; i += GT) { const int n = (int)(i & 31), hi = (int)(i >> 5) & 1, ks = (int)(i >> 6) & 7, kb = (int)(i >> 9) & 3; const size_t lhp = i >> 11;
          const float* src = A.in[IN_PSK] + (lhp * 128 + kb * 32 + n) * 128 + ks * 16 + hi * 8;
          const f32x4 a = *(const f32x4*)src, b = *(const f32x4*)(src + 4);
          v4u o; o.x = pk2(a.x, a.y); o.y = pk2(a.z, a.w); o.z = pk2(b.x, b.y); o.w = pk2(b.z, b.w);
          *(v4u*)((bf16*)(ws + WS_SUBK) + i * 8) = o; }
 }
}

__device__ __forceinline__ void phase_rownorm(const Args& A, const Frame& F0, int l, int kind, bool with_ctx) {
    const Frame F = refresh(F0);
    const int gw = F.vcu * NWAVES + F.wave, NGW = F.G * NWAVES;
    const float* gain = A.in[kind == 1 ? IN_N2G : IN_N1G] + l * 2048;
    const float* mod = (const float*)(A.ws + WS_MOD) + (size_t)l * 9 * 12288;
    const bf16* XSb = (const bf16*)(A.ws + WS_XS); unsigned char* HN = A.ws + WS_HN;
    const bool blocked = NGW * 9 == MROWS;
    const int nrow = blocked ? 9 : (MROWS - gw + NGW - 1) / NGW;
#define RN_ROW(k_) (blocked ? gw * 9 + (k_) : gw + (k_) * NGW)
#define RN_LOAD(V_, R_) do { const int Rl_ = (R_) < MROWS ? (R_) : 0; const int bl_ = Rl_ / TPB, tl_ = Rl_ % TPB; \
        const float* src_ = tl_ < CTXL ? A.in[IN_CTX] + (size_t)(bl_ * 256 + tl_) * 2048 : A.in[IN_X] + (size_t)(bl_ * 2048 + tl_ - 256) * 2048; \
        _Pragma("unroll") for (int j = 0; j < 8; ++j) { \
            if (kind) { const f32x2 w2 = *(const f32x2*)(XSb + (size_t)Rl_ * 2048 + j * 256 + F.lane * 4); const unsigned a_ = ((const unsigned*)&w2)[0], c_ = ((const unsigned*)&w2)[1]; V_[j] = (f32x4){bflo(a_), bfhi(a_), bflo(c_), bfhi(c_)}; } \
            else V_[j] = *(const f32x4*)(src_ + j * 256 + F.lane * 4); } } while (0)
    f32x4 av[8], sv[8]; int cur_m = -1;
    f32x4 vn[8];
    if (nrow > 0) RN_LOAD(vn, RN_ROW(0));
    for (int k = 0; k < nrow; ++k) {
        const int R = RN_ROW(k);
        f32x4 v[8];
#pragma unroll
        for (int j = 0; j < 8; ++j) v[j] = vn[j];
        if (k + 1 < nrow) RN_LOAD(vn, RN_ROW(k + 1));
        const int b = R / TPB, tp = R % TPB; const bool isc = tp < CTXL;
        if (isc && !with_ctx) continue;
        const int mrow = isc ? 8 : b;
        if (mrow != cur_m) { cur_m = mrow; const float* mr = mod + (size_t)mrow * 12288 + (kind == 1 ? 3 * 2048 : 0);
            f32x4 gt_[8], st_[8];
#pragma unroll
            for (int j = 0; j < 8; ++j) { const int col = j * 256 + F.lane * 4; gt_[j] = *(const f32x4*)(gain + col); st_[j] = *(const f32x4*)(mr + 2048 + col); sv[j] = *(const f32x4*)(mr + col); }
            __builtin_amdgcn_sched_barrier(0);
#pragma unroll
            for (int j = 0; j < 8; ++j) av[j] = gt_[j] * (st_[j] + 1.f); }
        float ss = 0.f;
#pragma unroll
        for (int j = 0; j < 8; ++j) ss += (v[j].x * v[j].x + v[j].y * v[j].y) + (v[j].z * v[j].z + v[j].w * v[j].w);
        const float rstd = rsqrtf(wave_sum(ss) * (1.f / 2048.f) + NEPS);
        float mx = 0.f;
#pragma unroll
        for (int j = 0; j < 8; ++j) { const int col = j * 256 + F.lane * 4;
            const f32x4 y = (v[j] * rstd) * av[j] + sv[j]; v[j] = y;
            mx = fmaxf(mx, fmaxf(fmaxf(fabsf(y.x), fabsf(y.y)), fmaxf(fabsf(y.z), fabsf(y.w))));
            if (kind == 1) { f32x2 o; ((unsigned*)&o)[0] = pk2(y.x, y.y); ((unsigned*)&o)[1] = pk2(y.z, y.w); *(f32x2*)((bf16*)HN + (size_t)R * 2048 + col) = o; }
            else *(unsigned*)(HN + (size_t)R * 2048 + col) = f8x4(y.x, y.y, y.z, y.w); }
        if (kind == 1) {
#pragma unroll
            for (int o = 1; o < 64; o <<= 1) mx = fmaxf(mx, __shfl_xor(mx, o));
            const float sc = mx > 0.f ? mx * (1.f / 240.f) : 1.f, inv = 1.f / sc;
            unsigned* dst = (unsigned*)(A.ws + WS_H8 + (size_t)R * 2048) + F.lane;
#pragma unroll
            for (int j = 0; j < 8; ++j) dst[j * 64] = f8x4(v[j].x * inv, v[j].y * inv, v[j].z * inv, v[j].w * inv);
            if (F.lane == 0) ((float*)(A.ws + WS_HS))[R] = sc;
        }
    }
#undef RN_ROW
#undef RN_LOAD
}

__device__ __forceinline__ void rope_apply(float& y1, float& y2, float ang) { float s, c; sincosf(ang, &s, &c); const float a = y1 * c - y2 * s, b2 = y1 * s + y2 * c; y1 = a; y2 = b2; }
__device__ __forceinline__ void phase_rope(const Args& A, const Frame& F0, int l) {
    const Frame F = refresh(F0);
    const int gw = F.vcu * NWAVES + F.wave, NGW = F.G * NWAVES, lane = F.lane;
    bf16* QKV = (bf16*)(A.ws + WS_QKV);
    const float* dqg = A.in[IN_DQG] + l * 64; const float* dkg = A.in[IN_DKG] + l * 64; const float* gqg = A.in[IN_GQG] + l * 128; const float* gkg = A.in[IN_GKG] + l * 128;
    const int hw = lane >> 5, li = lane & 31;
    const float if64 = exp2f(-(float)(2 * (li & 15)) * (13.287712379549449f / 32.f));
    const float if128 = exp2f(-(float)(2 * (lane & 31)) * (13.287712379549449f / 64.f));
    for (int R = gw; R < MROWS; R += NGW) {
        const int tp = R % TPB; const bool isc = tp < CTXL; const int t = tp - CTXL;
        const float prow = (float)(t >> 6), pcol = (float)(t & 63);
        bf16* q = QKV + (size_t)R * INC;
        const float ang64 = (li < 16 ? prow : pcol) * if64, ang128 = (lane < 32 ? prow : pcol) * if128;
#pragma unroll
        for (int s = 0; s < 8; ++s) {
            const bool isq = s < 4; if (isq && isc && l == 1) continue;
            const int v = 2 * (s & 3) + hw; unsigned* p = (unsigned*)(q + (isq ? DQ_OFF : DK_OFF) + v * 64) + li; const float* g = isq ? dqg : dkg;
            const unsigned w = *p; float x1 = bflo(w), x2 = bfhi(w);
            const float rstd = rsqrtf(half_sum32(x1 * x1 + x2 * x2) * (1.f / 64.f) + NEPS);
            x1 = x1 * rstd * g[2 * li]; x2 = x2 * rstd * g[2 * li + 1];
            if (!isc) rope_apply(x1, x2, ang64);
            *p = pk2(x1, x2);
        }
#pragma unroll
        for (int s = 0; s < 10; ++s) {
            const bool isq = s < 8; if (isq && isc && l == 1) continue;
            unsigned* p = (unsigned*)(q + (isq ? GQ_OFF + s * 128 : GK_OFF + (s - 8) * 128)) + lane; const float* g = isq ? gqg : gkg;
            const unsigned w = *p; float x1 = bflo(w), x2 = bfhi(w);
            const float rstd = rsqrtf(wave_sum(x1 * x1 + x2 * x2) * (1.f / 128.f) + NEPS);
            x1 = x1 * rstd * g[2 * lane]; x2 = x2 * rstd * g[2 * lane + 1];
            if (!isc) rope_apply(x1, x2, ang128);
            *p = pk2(x1, x2);
        }
        { f32x2* p = (f32x2*)(q + RK_OFF) + lane; f32x2 w = *p; unsigned a = ((unsigned*)&w)[0], b2 = ((unsigned*)&w)[1];
          ((unsigned*)&w)[0] = pk2(bflo(a) * 0.125f, bfhi(a) * 0.125f); ((unsigned*)&w)[1] = pk2(bflo(b2) * 0.125f, bfhi(b2) * 0.125f); *p = w; }
    }
}
__device__ __forceinline__ void ret_state_item(const Args& A, const Frame& F, int l, int item) {
    using namespace att;
    const int vq = item & 3, dir = (item >> 2) & 1, h = (item >> 3) & 3, b = item >> 5;
    const bf16* QKV = (const bf16*)(A.ws + WS_QKV) + (size_t)b * TPB * INC;
    float* RST = (float*)(A.ws + WS_RST) + (size_t)((b * 4 + h) * 2 + dir) * NCHUNK * 64 * 128;
    const float lg = ((const float*)(A.ws + WS_SCAL))[l * 16 + 2 + dir * 4 + h];
    const float cdec = exp2f(lg * 128.f);
    int tq = F.tid; asm volatile("" : "+v"(tq));
    const int lane = tq & 63, wid = tq >> 6, r32 = lane & 31, hi = lane >> 5;
    char* lds = (char*)F.ldsg;
    const int krow = tq >> 3, kch = (tq & 7) * 8, vrow = (tq >> 2) & 63, vch = (tq & 3) * 8;
    const int kst = v_st(krow, kch), vst = v_st(vrow, vch);
    const int rdb = v_rd_base(lane);
    f32x16 acc = f32x16{};
    bf16x8 kreg, vreg;
#define RS_LOAD(tile) do { const bf16* rp = QKV + (size_t)((tile) * 64) * INC; kreg = *(const bf16x8*)(rp + (size_t)krow * INC + RK_OFF + h * 64 + kch); \
        if (tq < 256) vreg = *(const bf16x8*)(rp + (size_t)vrow * INC + RV_OFF + h * 128 + vq * 32 + vch); } while (0)
#define RS_WRITE(set, tile) do { const int jj = (((tile) & 1) * 64 + krow); const float w = exp2f(lg * (float)(dir == 0 ? 127 - jj : jj)); \
        const v4u kw = __builtin_bit_cast(v4u, kreg); v4u o; o.x = pk2(bflo(kw.x) * w, bfhi(kw.x) * w); o.y = pk2(bflo(kw.y) * w, bfhi(kw.y) * w); o.z = pk2(bflo(kw.z) * w, bfhi(kw.z) * w); o.w = pk2(bflo(kw.w) * w, bfhi(kw.w) * w); \
        *(LAS v4u*)(F.lds + (set) * 32768 + kst) = o; if (tq < 256) *(LAS bf16x8*)(F.lds + (set) * 32768 + 16384 + vst) = vreg; } while (0)
#define RS_CHUNK(st) (dir == 0 ? (st) : ((st) == 0 ? 1 : ((st) == 1 ? 0 : 19 - (st))))
    RS_LOAD(2 * RS_CHUNK(0)); asm volatile("s_waitcnt vmcnt(0)" ::: "memory"); RS_WRITE(0, 2 * RS_CHUNK(0));
    RS_LOAD(2 * RS_CHUNK(0) + 1);
    __syncthreads();
    for (int st = 0; st < NCHUNK; ++st) {
        const int C = RS_CHUNK(st);
        if (wid < 2) {
#pragma unroll
            for (int r = 0; r < 16; ++r) RST[((size_t)C * 64 + wid * 32 + crow(r, hi)) * 128 + vq * 32 + r32] = acc[r];
            acc = acc * cdec; }
#pragma unroll
        for (int t2 = 0; t2 < 2; ++t2) {
            const int set = t2;
            if (wid < 2) {
                const int kb = (int)(uintptr_t)(lds + set * 32768) + rdb, vb = kb + 16384;
                s16x4 kl[4], kh[4], vl[4], vh[4];
                if (wid == 0) {
                    kl[0] = tr_read<v_rd_off(0, 0, 0)>(kb); kh[0] = tr_read<v_rd_off(0, 0, 1)>(kb); kl[1] = tr_read<v_rd_off(0, 1, 0)>(kb); kh[1] = tr_read<v_rd_off(0, 1, 1)>(kb);
                    kl[2] = tr_read<v_rd_off(0, 2, 0)>(kb); kh[2] = tr_read<v_rd_off(0, 2, 1)>(kb); kl[3] = tr_read<v_rd_off(0, 3, 0)>(kb); kh[3] = tr_read<v_rd_off(0, 3, 1)>(kb);
                } else {
                    kl[0] = tr_read<v_rd_off(1, 0, 0)>(kb); kh[0] = tr_read<v_rd_off(1, 0, 1)>(kb); kl[1] = tr_read<v_rd_off(1, 1, 0)>(kb); kh[1] = tr_read<v_rd_off(1, 1, 1)>(kb);
                    kl[2] = tr_read<v_rd_off(1, 2, 0)>(kb); kh[2] = tr_read<v_rd_off(1, 2, 1)>(kb); kl[3] = tr_read<v_rd_off(1, 3, 0)>(kb); kh[3] = tr_read<v_rd_off(1, 3, 1)>(kb);
                }
                vl[0] = tr_read<v_rd_off(0, 0, 0)>(vb); vh[0] = tr_read<v_rd_off(0, 0, 1)>(vb); vl[1] = tr_read<v_rd_off(0, 1, 0)>(vb); vh[1] = tr_read<v_rd_off(0, 1, 1)>(vb);
                vl[2] = tr_read<v_rd_off(0, 2, 0)>(vb); vh[2] = tr_read<v_rd_off(0, 2, 1)>(vb); vl[3] = tr_read<v_rd_off(0, 3, 0)>(vb); vh[3] = tr_read<v_rd_off(0, 3, 1)>(vb);
                asm volatile("s_waitcnt lgkmcnt(0)" ::: "memory"); ATT_SBAR();
#define RS_PK(L, H) (bf16x8){L[0], L[1], L[2], L[3], H[0], H[1], H[2], H[3]}
#pragma unroll
                for (int ks = 0; ks < 4; ++ks) acc = __builtin_amdgcn_mfma_f32_32x32x16_bf16(RS_PK(kl[ks], kh[ks]), RS_PK(vl[ks], vh[ks]), acc, 0, 0, 0);
#undef RS_PK
            }
            const int idx = st * 2 + t2;
            if (idx + 1 < 2 * NCHUNK) { asm volatile("s_waitcnt vmcnt(0)" ::: "memory"); RS_WRITE((idx + 1) & 1, ((idx + 1) & 1) + 2 * RS_CHUNK((idx + 1) >> 1)); }
            if (idx + 2 < 2 * NCHUNK) RS_LOAD(2 * RS_CHUNK((idx + 2) >> 1) + ((idx + 2) & 1));
            __syncthreads();
        }
    }
#undef RS_LOAD
#undef RS_WRITE
#undef RS_CHUNK
}

constexpr int OST_OFF = 69632;
__device__ __forceinline__ void ost_flush(LAS unsigned char* wl, unsigned char* dst  , int lane) {
    asm volatile("s_waitcnt lgkmcnt(0)" ::: "memory");
#pragma unroll
    for (int i = 0; i < 4; ++i) { const int row = i * 8 + (lane >> 3), ch = (lane & 7) * 16; *(v4u*)(dst + (size_t)row * 2048 + ch) = *(const LAS v4u*)(wl + row * 128 + ch); }
    asm volatile("s_waitcnt lgkmcnt(0)" ::: "memory");
}
__device__ __forceinline__ void phase_attention(const Args& A, const Frame& F0, int l, int sel = 7) {
    const Frame F = refresh(F0);
    using namespace att;
    const bf16* QKV = (const bf16*)(A.ws + WS_QKV); unsigned char* CAT = A.ws + WS_CAT; float* DSC = (float*)(A.ws + WS_DSC);
    char* lds = (char*)F.ldsg;
    const float* scal = (const float*)(A.ws + WS_SCAL) + l * 16;
    const bool nomax_g = __builtin_amdgcn_readfirstlane(__float_as_int(scal[10])) != 0, nomax_d = __builtin_amdgcn_readfirstlane(__float_as_int(scal[11])) != 0;
    if (sel & 1) for (int it = F.vcu; it < 256; it += F.G) ret_state_item(A, F, l, it);
    const int n_gqa = (sel & 2) ? 512 + (l == 0 ? 64 : 0) : 0;
    const bool spread = F.G == 256 && l == 0;
    for (int i0 = F.vcu; i0 < n_gqa + ((spread && n_gqa > 0) ? 64 : 0); i0 += F.G) {
        int i = i0; if (spread && i0 >= 512) { i = i0 - 64; if (i < 512) continue; }
        int tq = F.tid; asm volatile("" : "+v"(tq)); const int lane = tq & 63, wid = tq >> 6, r32 = lane & 31, hi = lane >> 5;
        int b, j, qrow0, seq;
        if (i < 512) { const int ug = (i & 255) * 2 + (i >> 8), grp = ug >> 5, within = ug & 31; b = grp >> 1; j = (grp & 1) * 4 + (within >> 3); qrow0 = b * TPB + CTXL + (within & 7) * 256; seq = TPB; }
        else { const int u = i - 512; b = u >> 3; j = u & 7; qrow0 = b * TPB; seq = CTXL; }
        const bf16* Qb = QKV + (size_t)qrow0 * INC + GQ_OFF + j * 128;
        const bf16* Kh = QKV + (size_t)b * TPB * INC + GK_OFF + (j >> 2) * 128;
        const bf16* Vh = QKV + (size_t)b * TPB * INC + GV_OFF + (j >> 2) * 128;
        f32x16 o[4]; float rli[16];
        if (nomax_g) attn_body<128, true>(Qb, Kh, Vh, seq, lds, o, rli, tq); else attn_body<128, false>(Qb, Kh, Vh, seq, lds, o, rli, tq);
        { LAS unsigned char* wl = F.lds + OST_OFF + wid * 4096 + (4 * hi) * 128 + r32;
#pragma unroll
          for (int r = 0; r < 16; ++r) {
#pragma unroll
            for (int d0 = 0; d0 < 4; ++d0) wl[((r & 3) + 8 * (r >> 2)) * 128 + d0 * 32] = (unsigned char)f8x1((DBG & 2) ? o[d0][r] * rli[r] * GQA8_SCALE : 0.f); }
          ost_flush(F.lds + OST_OFF + wid * 4096, CAT + (size_t)(qrow0 + wid * 32) * 2048 + 512 + j * 128, lane); }
        __syncthreads();
    }
    const int n_diff = (sel & 4) ? 256 + (l == 0 ? 32 : 0) : 0;
    const float lam = scal[0], lam_init = scal[1];
    const float* dog = A.in[IN_DOG] + l * 128;
    for (int i0 = F.vcu; i0 < n_diff + ((spread && n_diff > 0) ? 128 : 0); i0 += F.G) {
        int i = i0; if (spread && i0 >= 256) { i = i0 - 128; if (i < 256) continue; }
        int tq = F.tid; asm volatile("" : "+v"(tq)); const int lane = tq & 63, wid = tq >> 6, r32 = lane & 31, hi = lane >> 5;
        int b, h, qrow0, seq;
        if (i < 256) { const int grp = i >> 3; b = grp >> 2; h = grp & 3; qrow0 = b * TPB + CTXL + (i & 7) * 256; seq = TPB; }
        else { const int u = i - 256; b = u >> 2; h = u & 3; qrow0 = b * TPB; seq = CTXL; }
        const bf16* Vh = QKV + (size_t)b * TPB * INC + DV_OFF + h * 128;
        const rsrc_t srr = mk_rsrc(DSC + (size_t)qrow0 * 512 + h * 128, 256 * 512 * 4); const unsigned slo = (unsigned)((wid * 32 + 4 * hi) * 512 + r32) * 4u;
        {
            f32x16 o[4]; float rli[16];
            if (nomax_d) attn_body<64, true>(QKV + (size_t)qrow0 * INC + DQ_OFF + h * 128, QKV + (size_t)b * TPB * INC + DK_OFF + h * 128, Vh, seq, lds, o, rli, tq);
            else attn_body<64, false>(QKV + (size_t)qrow0 * INC + DQ_OFF + h * 128, QKV + (size_t)b * TPB * INC + DK_OFF + h * 128, Vh, seq, lds, o, rli, tq);
#pragma unroll
            for (int r = 0; r < 16; ++r) {
#pragma unroll
                for (int d0 = 0; d0 < 4; ++d0) BST32F(o[d0][r] * rli[r], srr, slo, (((r & 3) + 8 * (r >> 2)) * 512 + d0 * 32) * 4); }
            __syncthreads();
        }
        {
            f32x16 o[4]; float rli[16];
            if (nomax_d) attn_body<64, true>(QKV + (size_t)qrow0 * INC + DQ_OFF + h * 128 + 64, QKV + (size_t)b * TPB * INC + DK_OFF + h * 128 + 64, Vh, seq, lds, o, rli, tq);
            else attn_body<64, false>(QKV + (size_t)qrow0 * INC + DQ_OFF + h * 128 + 64, QKV + (size_t)b * TPB * INC + DK_OFF + h * 128 + 64, Vh, seq, lds, o, rli, tq);
            LAS unsigned char* wl = F.lds + OST_OFF + wid * 4096 + (4 * hi) * 128 + r32;
            float gv[4];
#pragma unroll
            for (int d0 = 0; d0 < 4; ++d0) gv[d0] = dog[d0 * 32 + r32] * (1.f - lam_init);
#pragma unroll
            for (int rg = 0; rg < 4; ++rg) { float d0v[4][4];
#pragma unroll
                for (int q = 0; q < 4; ++q)
#pragma unroll
                    for (int d0 = 0; d0 < 4; ++d0) { const int r = rg * 4 + q; d0v[q][d0] = BLD32F(srr, slo, (((r & 3) + 8 * (r >> 2)) * 512 + d0 * 32) * 4); }
                __builtin_amdgcn_sched_barrier(0);
#pragma unroll
                for (int q = 0; q < 4; ++q) { const int r = rg * 4 + q; float dv[4]; float ss = 0.f;
#pragma unroll
                    for (int d0 = 0; d0 < 4; ++d0) { dv[d0] = d0v[q][d0] - lam * (o[d0][r] * rli[r]); ss += dv[d0] * dv[d0]; }
                    const float rstd = rsqrtf(half_sum32(ss) * (1.f / 128.f) + NEPS);
#pragma unroll
                    for (int d0 = 0; d0 < 4; ++d0) wl[((r & 3) + 8 * (r >> 2)) * 128 + d0 * 32] = (unsigned char)f8x1((DBG & 1) ? dv[d0] * rstd * gv[d0] : 0.f); }
                __builtin_amdgcn_sched_barrier(0); }
            ost_flush(F.lds + OST_OFF + wid * 4096, CAT + (size_t)(qrow0 + wid * 32) * 2048 + h * 128, lane);
            __syncthreads();
        }
    }
}

__device__ __forceinline__ void phase_retention_out(const Args& A, const Frame& F0, int l) {
    const Frame F = refresh(F0);
    using namespace att;
    const bf16* QKV = (const bf16*)(A.ws + WS_QKV); unsigned char* CAT = A.ws + WS_CAT;
    char* lds = (char*)F.ldsg;
    const float* scal = (const float*)(A.ws + WS_SCAL) + l * 16;
    const float* rog = A.in[IN_ROG] + l * 128;
    const int nP = l == 0 ? 9 : 8, nU = 32 * nP;
    for (int u = F.vcu; u < nU; u += F.G) {
        int tq = F.tid; asm volatile("" : "+v"(tq));
        const int tid = tq, lane = tq & 63, wid = tq >> 6, r32 = lane & 31, hi = lane >> 5;
        const int sr = tq >> 4, sc = (tq & 15) * 8, kr = tq >> 3, kc = (tq & 7) * 8;
        const int vb0 = (int)(uintptr_t)lds + v_rd_base(tq & 63);
        const int P = u % nP + (l == 0 ? 0 : 1), bh = u / nP, h = bh & 3, b = bh >> 2;
        const int R0 = b * TPB + P * 256;
        const float lgf = scal[2 + h], lgb = scal[6 + h];
#pragma unroll 1
        for (int t = 0; t < 4; ++t) {
            const bf16* rp = QKV + (size_t)(R0 + t * 64) * INC;
            const bf16x8 v0 = *(const bf16x8*)(rp + (size_t)sr * INC + RV_OFF + h * 128 + sc), v1 = *(const bf16x8*)(rp + (size_t)(32 + sr) * INC + RV_OFF + h * 128 + sc);
            const bf16x8 k0 = *(const bf16x8*)(rp + (size_t)kr * INC + RK_OFF + h * 64 + kc);
            *(bf16x8*)(lds + t * 16384 + v_st(sr, sc)) = v0; *(bf16x8*)(lds + t * 16384 + v_st(32 + sr, sc)) = v1;
            *(bf16x8*)(lds + 65536 + t * 8192 + koff<64>(kr, kc * 2)) = k0;
        }
        bf16x8 qr[4];
        { const bf16* Qw = QKV + (size_t)(R0 + wid * 32 + r32) * INC + RQ_OFF + h * 64 + hi * 8;
#pragma unroll
          for (int d0 = 0; d0 < 4; ++d0) qr[d0] = *(const bf16x8*)(Qw + d0 * 16); }
        __syncthreads();
        const int cp = wid >> 2; int ipos = (wid & 3) * 32 + r32; asm volatile("" : "+v"(ipos));
        int hiv = hi; asm volatile("" : "+v"(hiv));
        f32x16 o[4];
#pragma unroll
        for (int d = 0; d < 4; ++d) o[d] = f32x16{};
#pragma unroll
        for (int t2 = 0; t2 < 2; ++t2) {
            const int t = cp * 2 + t2;
            f32x16 p0, p1; qkt<64>(p0, p1, lds + 65536 + t * 8192, qr, r32, hi);
#pragma unroll
            for (int r = 0; r < 16; ++r) { const int j0 = t2 * 64 + crow(r, hiv), d0_ = ipos - j0, d1_ = d0_ - 32;
                p0[r] *= d0_ >= 0 ? exp2f(lgf * (float)d0_) : exp2f(lgb * (float)(-d0_));
                p1[r] *= d1_ >= 0 ? exp2f(lgf * (float)d1_) : exp2f(lgb * (float)(-d1_)); }
            bf16x8 pa0, pa1, pa2, pa3;
            ATT_PK4(p0, 0, pa0); ATT_PK4(p0, 8, pa1); ATT_PK4(p1, 0, pa2); ATT_PK4(p1, 8, pa3);
            pv_d0(o, vb0 + t * 16384, pa0, pa1, pa2, pa3);
        }
        __syncthreads();
        { const int d = tid >> 3, v0 = (tid & 7) * 16;
#pragma unroll 1
          for (int img = 0; img < 4; ++img) { const int cpi = img >> 1, dir = img & 1, C = 2 * P + cpi;
              const float* sp = (const float*)(A.ws + WS_RST) + ((size_t)(((b * 4 + h) * 2 + dir) * NCHUNK + C) * 64 + d) * 128 + v0;
              const f32x4 a = *(const f32x4*)(sp), bq = *(const f32x4*)(sp + 4), c = *(const f32x4*)(sp + 8), e = *(const f32x4*)(sp + 12);
              v4u w0, w1; w0.x = pk2(a.x, a.y); w0.y = pk2(a.z, a.w); w0.z = pk2(bq.x, bq.y); w0.w = pk2(bq.z, bq.w);
              w1.x = pk2(c.x, c.y); w1.y = pk2(c.z, c.w); w1.z = pk2(e.x, e.y); w1.w = pk2(e.z, e.w);
              *(v4u*)(lds + img * 16384 + v_st(d, v0)) = w0; *(v4u*)(lds + img * 16384 + v_st(d, v0 + 8)) = w1; } }
        __syncthreads();
#pragma unroll
        for (int dir = 0; dir < 2; ++dir) {
            const float qs = dir == 0 ? exp2f(lgf * (float)(ipos + 1)) : exp2f(lgb * (float)(128 - ipos));
            bf16x8 pa[4];
#pragma unroll
            for (int ks = 0; ks < 4; ++ks) { v4u w = __builtin_bit_cast(v4u, qr[ks]);
                w.x = pk2(bflo(w.x) * qs, bfhi(w.x) * qs); w.y = pk2(bflo(w.y) * qs, bfhi(w.y) * qs); w.z = pk2(bflo(w.z) * qs, bfhi(w.z) * qs); w.w = pk2(bflo(w.w) * qs, bfhi(w.w) * qs);
                pa[ks] = __builtin_bit_cast(bf16x8, w); }
            pv_d0(o, vb0 + (cp * 2 + dir) * 16384, pa[0], pa[1], pa[2], pa[3]);
        }
        { const rsrc_t grr = mk_rsrc(QKV + (size_t)R0 * INC + RG_OFF + h * 128, 256 * INC * 2); const unsigned glo = (unsigned)((wid * 32 + 4 * hi) * INC + r32) * 2u;
          LAS unsigned char* wl = F.lds + 98304 + wid * 4096 + (4 * hi) * 128 + r32;
          float gv[4];
#pragma unroll
          for (int d0 = 0; d0 < 4; ++d0) gv[d0] = rog[d0 * 32 + r32];
#pragma unroll
          for (int rg = 0; rg < 4; ++rg) {
              unsigned short gtw[4][4];
#pragma unroll
              for (int q = 0; q < 4; ++q)
#pragma unroll
                  for (int d0 = 0; d0 < 4; ++d0) { const int r = rg * 4 + q; gtw[q][d0] = BLD16(grr, glo, (((r & 3) + 8 * (r >> 2)) * INC + d0 * 32) * 2); }
#pragma unroll
              for (int q = 0; q < 4; ++q) { const int r = rg * 4 + q; float ss = 0.f;
#pragma unroll
                  for (int d0 = 0; d0 < 4; ++d0) ss += o[d0][r] * o[d0][r];
                  const float rstd = rsqrtf(half_sum32(ss) * (1.f / 128.f) + NEPS);
#pragma unroll
                  for (int d0 = 0; d0 < 4; ++d0) { const float y = o[d0][r] * rstd * gv[d0]; const float gt = bf2f(gtw[q][d0]);
                      wl[((r & 3) + 8 * (r >> 2)) * 128 + d0 * 32] = (unsigned char)f8x1((DBG & 4) ? siluf(gt) * y : 0.f); } }
              asm volatile("" ::: "memory"); }
          ost_flush(F.lds + 98304 + wid * 4096, CAT + (size_t)(R0 + wid * 32) * 2048 + 1536 + h * 128, lane); }
        __syncthreads();
    }
}
#ifndef DBG_CHECK
#define DBG_CHECK 0
#endif
constexpr size_t WS_CHK = 880 * MiB;
constexpr int CHK_NT = 64;
__device__ __forceinline__ int chk_row(int i) { return 37 * i * 7 + 261; }
__device__ __forceinline__ void chk_fail(const Args& A, int k) { atomicAdd((unsigned*)(A.ws + WS_CTL) + 512 + k, 1u); }
__device__ __forceinline__ float gelu_exact(float z) { return 0.5f * z * (1.f + erff(z * 0.70710678118654752f)); }
__device__ __forceinline__ void chk_save(const Args& A, int tid) {
    float* SH = (float*)(A.ws + WS_CHK); float* SX = SH + CHK_NT * 2048;
    const bf16* HN = (const bf16*)(A.ws + WS_HN); const bf16* XS = (const bf16*)(A.ws + WS_XS);
    for (int i = tid; i < CHK_NT * 2048; i += NTHR) { const int s = i >> 11, c = i & 2047, R = chk_row(s); SH[i] = bf2f(HN[(size_t)R * 2048 + c]); SX[i] = bf2f(XS[(size_t)R * 2048 + c]); }
}
__device__ __forceinline__ void chk_qp_topk(const Args& A, int tid) {
    const float* SH = (const float*)(A.ws + WS_CHK);
    const bf16* QP = (const bf16*)(A.ws + WS_QKV);
    const float* WQ = A.in[IN_PWQ];
    { const int s = tid >> 3, cc = (tid & 7) * 251 + 3, R = chk_row(s); float acc = 0.f;
      for (int k = 0; k < 2048; ++k) acc += SH[s * 2048 + k] * WQ[(size_t)k * 2048 + cc];
      const float got = bf2f(QP[pg8::qp_frag_index(R, cc)]);
      if (!(fabsf(got - acc) <= 0.02f * fabsf(acc) + 0.05f)) chk_fail(A, 1); }
    { const int s = tid >> 3, h = tid & 7, R = chk_row(s);
      float* sc = (float*)(A.ws + WS_CHK) + 4 * CHK_NT * 2048 + (size_t)tid * 1024;
      const float* SKf = A.in[IN_PSK] + (size_t)h * 2 * 128 * 128;
      for (int p = 0; p < 2; ++p) for (int k = 0; k < 128; ++k) { float a = 0.f;
          for (int d = 0; d < 128; ++d) a += bf2f(QP[pg8::qp_frag_index(R, h * 256 + p * 128 + d)]) * SKf[(size_t)(p * 128 + k) * 128 + d];
          sc[p * 128 + k] = a; }
      float* tv = sc + 256; float* cs = sc + 320;
      for (int p = 0; p < 2; ++p) for (int t = 0; t < 16; ++t) { int bi = 0; float bv = -INFINITY;
          for (int k = 0; k < 128; ++k) if (sc[p * 128 + k] > bv) { bv = sc[p * 128 + k]; bi = k; }
          tv[p * 16 + t] = bv; tv[32 + p * 16 + t] = (float)bi; sc[p * 128 + bi] = -INFINITY; }
      for (int a = 0; a < 16; ++a) for (int b2 = 0; b2 < 16; ++b2) cs[a * 16 + b2] = tv[a] + tv[16 + b2];
      const int* ip = (const int*)(A.ws + WS_PIDX) + (size_t)R * 128 + h * 16; const float* gp = (const float*)(A.ws + WS_PGATE) + (size_t)R * 128 + h * 16;
      int miss = 0; float gsum = 0.f;
      for (int t = 0; t < 16; ++t) { int bi = 0; float bv = -INFINITY;
          for (int k = 0; k < 256; ++k) if (cs[k] > bv) { bv = cs[k]; bi = k; }
          cs[bi] = -INFINITY; const int id = (int)tv[32 + (bi >> 4)] * 128 + (int)tv[48 + (bi & 15)];
          bool found = false; for (int q = 0; q < 16; ++q) found |= ip[q] == id;
          if (!found) ++miss; }
      for (int q = 0; q < 16; ++q) { gsum += gp[q]; if (!(ip[q] >= 0 && ip[q] < NEXP)) miss += 100; }
      if (miss > 3) chk_fail(A, 2);
      if (!(fabsf(gsum - 1.f) < 1e-3f)) chk_fail(A, 3); }
}
__device__ __forceinline__ void chk_experts(const Args& A, int tid) {
    const float* SH = (const float*)(A.ws + WS_CHK); const float* SX = SH + CHK_NT * 2048;
    float* ACT = (float*)(A.ws + WS_CHK) + 2 * CHK_NT * 2048;
    const float* U = A.in[IN_PU]; const float* V = A.in[IN_PV];
    for (int i = tid; i < CHK_NT * 128; i += NTHR) { const int s = i >> 7, e = i & 127, R = chk_row(s);
        const int id = ((const int*)(A.ws + WS_PIDX))[(size_t)R * 128 + e]; const float g = ((const float*)(A.ws + WS_PGATE))[(size_t)R * 128 + e];
        float z = 0.f; for (int k = 0; k < 2048; ++k) z += SH[s * 2048 + k] * U[(size_t)id * 2048 + k];
        ACT[i] = gelu_exact(z) * g; }
    __syncthreads(); __threadfence_block();
    { const int s = tid >> 3, cc = (tid & 7) * 251 + 5, R = chk_row(s), b = R / TPB; const bool isc = (R % TPB) < CTXL;
      float o = 0.f; for (int e = 0; e < 128; ++e) { const int id = ((const int*)(A.ws + WS_PIDX))[(size_t)R * 128 + e]; o += ACT[s * 128 + e] * V[(size_t)id * 2048 + cc]; }
      const float g2 = ((const float*)(A.ws + WS_MOD))[(size_t)(isc ? 8 : b) * 12288 + 5 * 2048 + cc];
      const float want = SX[s * 2048 + cc] + g2 * o, got = bf2f(((const bf16*)(A.ws + WS_XS))[(size_t)R * 2048 + cc]);
      if (!(fabsf(got - want) <= 0.06f * fabsf(g2 * o) + 0.03f + 0.01f * fabsf(want))) chk_fail(A, 4); }
}
__device__ __forceinline__ float chk_code(const Args& A) {
    const unsigned* e = (const unsigned*)(A.ws + WS_CTL) + 512;
    for (int k = 1; k < 8; ++k) if (__hip_atomic_load(e + k, __ATOMIC_RELAXED, __HIP_MEMORY_SCOPE_AGENT)) return (float)k;
    return 0.f;
}
typedef float f32x16 __attribute__((ext_vector_type(16)));
__device__ __forceinline__ float swap_max(float m) { auto rr = __builtin_amdgcn_permlane32_swap(__float_as_uint(m), __float_as_uint(m), false, false); return fmaxf(__uint_as_float(rr[0]), __uint_as_float(rr[1])); }
__device__ __forceinline__ int peer_row(int l, int idx) { return l == 0 ? idx : (idx >> 11) * TPB + CTXL + (idx & 2047); }
#define PT_CE(x, y) do { const float mx_ = fmaxf(x, y), mn_ = fminf(x, y); x = mx_; y = mn_; } while (0)
template <class V> __device__ __forceinline__ void pt_sort16(V& v) {
#pragma unroll
    for (int k = 2; k <= 16; k <<= 1)
#pragma unroll
        for (int j = k >> 1; j > 0; j >>= 1)
#pragma unroll
            for (int i = 0; i < 16; ++i) { const int p = i ^ j; if (p > i) { if ((i & k) == 0) { float a = v[i], b = v[p]; PT_CE(a, b); v[i] = a; v[p] = b; } else { float a = v[p], b = v[i]; PT_CE(a, b); v[p] = a; v[i] = b; } } }
}
template <class V> __device__ __forceinline__ void pt_merge16(V& v) {
#pragma unroll
    for (int j = 8; j > 0; j >>= 1)
#pragma unroll
        for (int i = 0; i < 16; ++i) { const int p = i ^ j; if (p > i) { float a = v[i], b = v[p]; PT_CE(a, b); v[i] = a; v[p] = b; } }
}
template <class V, class W> __device__ __forceinline__ void pt_top16(V& a, const W& b) {
#pragma unroll
    for (int i = 0; i < 16; ++i) a[i] = fmaxf(a[i], b[15 - i]);
    pt_merge16(a);
}
__device__ __forceinline__ void peer_topk_task(const Args& A, int l, int R0, int h, int lane, LAS unsigned* wscr, const LAS unsigned char* skl  ) {
    asm volatile("" : "+v"(lane));
    const int n = lane & 31; int hi = lane >> 5; asm volatile("" : "+v"(hi));
    const bf16* QP = (const bf16*)(A.ws + WS_QKV);
    const bf16* SK = (const bf16*)(A.ws + WS_SUBK) + (size_t)(l * 8 + h) * 2 * 128 * 128;
    f32x16 sel[2];
#pragma unroll
    for (int p = 0; p < 2; ++p) {
        bf16x8 qf[8];
        const bf16* qp = QP + ((((size_t)(R0 >> 5) * 8 + h) * 2 + p) * 8 * 2 * 32 + lane) * 8;
#pragma unroll
        for (int ks = 0; ks < 8; ++ks) qf[ks] = *(const bf16x8*)(qp + ks * 512);
        f32x16 sc[4];
#pragma unroll
        for (int kb = 0; kb < 4; ++kb) { sc[kb] = f32x16{};
            const bf16* kp = SK + ((size_t)(p * 4 + kb) * 8 * 2 * 32 + lane) * 8;
            if (skl) { const LAS unsigned char* kl = skl + ((size_t)(p * 4 + kb) * 8 * 2 * 32 + lane) * 16;
#pragma unroll
                for (int ks = 0; ks < 8; ++ks) sc[kb] = __builtin_amdgcn_mfma_f32_32x32x16_bf16(*(const LAS bf16x8*)(kl + ks * 1024), qf[ks], sc[kb], 0, 0, 0); }
            else {
#pragma unroll
                for (int ks = 0; ks < 8; ++ks) sc[kb] = __builtin_amdgcn_mfma_f32_32x32x16_bf16(*(const bf16x8*)(kp + ks * 512), qf[ks], sc[kb], 0, 0, 0); }
            __builtin_amdgcn_sched_barrier(0); }
#pragma unroll
        for (int kb = 0; kb < 4; ++kb)
#pragma unroll
            for (int r = 0; r < 16; ++r) { const unsigned key = (unsigned)(kb * 32 + (r & 3) + 8 * (r >> 2) + 4 * hi); sc[kb][r] = __uint_as_float((__float_as_uint(sc[kb][r]) & ~127u) | key); }
        pt_sort16(sc[0]); pt_sort16(sc[1]); pt_sort16(sc[2]); pt_sort16(sc[3]);
        pt_top16(sc[0], sc[1]); pt_top16(sc[2], sc[3]); pt_top16(sc[0], sc[2]);
        f32x16 pb;
#pragma unroll
        for (int i = 0; i < 16; ++i) { auto rr = __builtin_amdgcn_permlane32_swap(__float_as_uint(sc[0][i]), __float_as_uint(sc[0][i]), false, false); pb[i] = __uint_as_float(hi ? rr[0] : rr[1]); }
        pt_top16(sc[0], pb);
        sel[p] = sc[0];
    }
    f32x16 cd[4];
#pragma unroll
    for (int g = 0; g < 4; ++g)
#pragma unroll
        for (int i = 0; i < 16; ++i) cd[g][i] = -INFINITY;
    { int c = 0;
#pragma unroll
      for (int a = 0; a < 16; ++a)
#pragma unroll
          for (int b2 = 0; b2 < 16; ++b2) if ((a + 1) * (b2 + 1) <= 16) { cd[c >> 4][c & 15] = __uint_as_float((__float_as_uint(sel[0][a] + sel[1][b2]) & ~255u) | (unsigned)(a * 16 + b2)); ++c; } }
    pt_sort16(cd[0]); pt_sort16(cd[1]); pt_sort16(cd[2]); pt_sort16(cd[3]);
    pt_top16(cd[0], cd[1]); pt_top16(cd[2], cd[3]); pt_top16(cd[0], cd[2]);
#pragma unroll
    for (int q = 0; q < 16; ++q) { wscr[q * 64 + lane] = __float_as_uint(sel[0][q]) & 127u; wscr[(16 + q) * 64 + lane] = __float_as_uint(sel[1][q]) & 127u; }
    float e[16], es = 0.f; int ids[16];
#pragma unroll
    for (int t = 0; t < 16; ++t) { const unsigned bits = __float_as_uint(cd[0][t]) & 255u; const unsigned a = bits >> 4, b2 = bits & 15u;
        ids[t] = (int)(wscr[a * 64 + lane] * 128u + wscr[(16 + b2) * 64 + lane]); e[t] = __expf(cd[0][t] - cd[0][0]); es += e[t]; }
    const float inv = 1.f / es;
    if (hi == 0) {
        int* ip = (int*)(A.ws + WS_PIDX) + (size_t)(R0 + n) * 128 + h * 16; float* gp = (float*)(A.ws + WS_PGATE) + (size_t)(R0 + n) * 128 + h * 16;
#pragma unroll
        for (int t = 0; t < 16; ++t) { ip[t] = ids[t]; gp[t] = e[t] * inv; }
    }
}
__device__ __forceinline__ void phase_peer_topk(const Args& A, const Frame& F0, int l) {
    const Frame F = refresh(F0);
    const int ngrp = (l == 0 ? MROWS : NB * SEQL) / 32;
    if (F.G % 8 == 0) {
        const int h = F.vcu & 7, wq = (F.vcu >> 3) * NWAVES + F.wave, nwq = (F.G >> 3) * NWAVES;
        { const v4u* src = (const v4u*)((const bf16*)(A.ws + WS_SUBK) + (size_t)(l * 8 + h) * 2 * 128 * 128);
#pragma unroll
          for (int i = 0; i < 8; ++i) *(LAS v4u*)(F.lds + 65536 + (i * NTHR + F.tid) * 16) = src[i * NTHR + F.tid]; }
        __syncthreads();
        for (int tg = wq; tg < ngrp; tg += nwq) peer_topk_task(A, l, peer_row(l, tg * 32), h, F.lane, (LAS unsigned*)(F.lds + F.wave * 8192), F.lds + 65536);
    } else {
        const int gw = F.vcu * NWAVES + F.wave, NGW = F.G * NWAVES;
        for (int tk = gw; tk < ngrp * 8; tk += NGW) { const int tg = tk >> 3, h = tk & 7; peer_topk_task(A, l, peer_row(l, tg * 32), h, F.lane, (LAS unsigned*)(F.lds + F.wave * 8192), nullptr); }
    }
}

constexpr int NGRP = 16;
__device__ __forceinline__ float gelu_erf(float z) { return 0.5f * z * (1.f + erff(z * 0.70710678118654752f)); }
__device__ __forceinline__ int sdot16(const v4u a, const v4u b, int acc) {
    const unsigned a0 = a.x, a1 = a.y, a2 = a.z, a3 = a.w, b0 = b.x, b1 = b.y, b2 = b.z, b3 = b.w;
    acc = __builtin_amdgcn_sdot4((int)a0, (int)b0, acc, false); acc = __builtin_amdgcn_sdot4((int)a1, (int)b1, acc, false);
    acc = __builtin_amdgcn_sdot4((int)a2, (int)b2, acc, false); acc = __builtin_amdgcn_sdot4((int)a3, (int)b3, acc, false);
    return acc;
}
typedef int i32x4v __attribute__((ext_vector_type(4)));
typedef int i32x8v __attribute__((ext_vector_type(8)));
constexpr int NGRP_U = 8;
__device__ __forceinline__ void phase_peer_u(const Args& A, const Frame& F0, int l, int pmode = 0) {
    const Frame F = refresh(F0);
    const int lane = F.lane;
    const int amask = pmode == 1 ? 63 : 0xFFFF;
    const int nvx = F.pnx, vx = F.px, rank = F.prank, nrank = F.pcnt;
    const int ntok = l == 0 ? MROWS : NB * SEQL;
    const unsigned char* U4 = A.ws + WS_U8 + (size_t)l * NEXP * 1024;
    const rsrc_t urs = mk_rsrc(U4, (unsigned)NEXP * 1024u);
    const float* US = (const float*)(A.ws + WS_US) + l * NEXP; const float* VS = (const float*)(A.ws + WS_VS) + l * NEXP;
    const signed char* H8 = (const signed char*)(A.ws + WS_H8); const float* HS = (const float*)(A.ws + WS_HS);
    const int* PIDX = (const int*)(A.ws + WS_PIDX); const float* PGATE = (const float*)(A.ws + WS_PGATE); unsigned* ACT = (unsigned*)(A.ws + WS_ACT);
    const int kg = lane >> 4, e4 = (lane >> 2) & 3, sl4 = lane & 3;
    const unsigned lbyte = (unsigned)(kg * 64 + sl4 * 16);
    const unsigned hbyte = (unsigned)(kg * 128 + sl4 * 32);
    const int eL = 4 * e4 + kg;
    const bool epi_lane = sl4 == 0;
    LAS unsigned* list = (LAS unsigned*)(F.lds + F.wave * 5120);
    LAS unsigned char* hb = F.lds + F.wave * 5120 + 1024;
    const int stride = nrank * NWAVES, t0 = rank * NWAVES + F.wave;
    constexpr unsigned OOB = 0x80000000u;
    for (int g = vx; g < NGRP_U; g += nvx) {
        int tcur = t0 - stride;
        int nR = peer_row(l, t0 < ntok ? t0 : 0);
        int nidA = PIDX[(size_t)nR * 128 + lane], nidB = PIDX[(size_t)nR * 128 + 64 + lane];
        v4u nh0 = *(const v4u*)(H8 + (size_t)nR * 2048 + lane * 16), nh1 = *(const v4u*)(H8 + (size_t)nR * 2048 + 1024 + lane * 16);
        float nhs = HS[nR];
        int par = 0, bi = 0, cnt = 0, R = 0; float hs = 0.f;
        int cR, cpar, cent; float chs; unsigned cv0, cv1, cv2, cv3; bool clive;
        int xR, xpar, xent; float xhs; unsigned xv0, xv1, xv2, xv3; bool xlive;
#define U_VO(qd) ({ const int ix_ = bi * 16 + 4 * (qd) + e4; const unsigned e_ = list[par * 128 + (ix_ & 127)]; \
                    ix_ < cnt ? (unsigned)((int)(e_ & 0xffffu) & amask) * 1024u + lbyte : OOB; })
#define U_SETUP() do { \
        if ((bi + 1) * 16 < cnt) ++bi; \
        else { tcur += stride; bi = 0; par ^= 1; R = nR; hs = nhs; \
            *(LAS v4u*)(hb + par * 2048 + lane * 16) = nh0; *(LAS v4u*)(hb + par * 2048 + 1024 + lane * 16) = nh1; \
            const bool ex_ = tcur < ntok; \
            const bool inA = ex_ && (nidA >> 11) == g, inB = ex_ && (nidB >> 11) == g; \
            const unsigned long long balA = __ballot(inA), balB = __ballot(inB); \
            const int cntA = __builtin_popcountll(balA); cnt = cntA + __builtin_popcountll(balB); \
            const int posA = (int)__builtin_amdgcn_mbcnt_hi((unsigned)(balA >> 32), __builtin_amdgcn_mbcnt_lo((unsigned)balA, 0u)); \
            const int posB = cntA + (int)__builtin_amdgcn_mbcnt_hi((unsigned)(balB >> 32), __builtin_amdgcn_mbcnt_lo((unsigned)balB, 0u)); \
            if (inA) list[par * 128 + posA] = (unsigned)nidA | ((unsigned)lane << 16); \
            if (inB) list[par * 128 + posB] = (unsigned)nidB | ((unsigned)(64 + lane) << 16); } \
        xlive = tcur < ntok; \
        { const int tq = tcur + stride < ntok ? tcur + stride : 0; nR = peer_row(l, tq); \
          nidA = PIDX[(size_t)nR * 128 + lane]; nidB = PIDX[(size_t)nR * 128 + 64 + lane]; \
          nh0 = *(const v4u*)(H8 + (size_t)nR * 2048 + lane * 16); nh1 = *(const v4u*)(H8 + (size_t)nR * 2048 + 1024 + lane * 16); nhs = HS[nR]; } \
        xR = R; xhs = hs; xpar = par; \
        xv0 = U_VO(0); xv1 = U_VO(1); xv2 = U_VO(2); xv3 = U_VO(3); \
        const unsigned e1 = list[par * 128 + ((bi * 16 + eL) & 127)]; \
        xent = (epi_lane && bi * 16 + eL < cnt) ? (int)e1 : -1; } while (0)
#define U_BLOADS(B, va, vb) do { _Pragma("unroll") for (int c = 0; c < 4; ++c) { B[c] = BLD128(urs, (va) + (unsigned)(c * 256), 0); B[4 + c] = BLD128(urs, (vb) + (unsigned)(c * 256), 0); } } while (0)
#define U_MFMA(B, ho, accA, accB) do { _Pragma("unroll") for (int c = 0; c < 4; ++c) { \
            const i32x4v hlo = *(const LAS i32x4v*)(hb + (ho) + c * 512 + hbyte2), hhi = *(const LAS i32x4v*)(hb + (ho) + c * 512 + hbyte2 + 256); \
            const i32x8v hv = {hlo.x, hlo.y, hlo.z, hlo.w, hhi.x, hhi.y, hhi.z, hhi.w}; \
            asm volatile("v_mfma_scale_f32_16x16x128_f8f6f4 %0, %1, %2, %0, %3, %4 op_sel_hi:[0,0,0] cbsz:4" : "+v"(accA) : "v"(B[c]), "v"(hv), "v"(sc1), "v"(sc1)); \
            asm volatile("v_mfma_scale_f32_16x16x128_f8f6f4 %0, %1, %2, %0, %3, %4 op_sel_hi:[0,0,0] cbsz:4" : "+v"(accB) : "v"(B[4 + c]), "v"(hv), "v"(sc1), "v"(sc1)); } } while (0)
        const unsigned hbyte2 = (unsigned)((kg >> 1) * 128 + sl4 * 32 + (kg & 1) * 16);
        int sc1 = 127; asm volatile("" : "+v"(sc1));
        v4u b0[8], b1[8];
        U_SETUP();
        clive = xlive; cR = xR; cpar = xpar; cent = xent; chs = xhs; cv0 = xv0; cv1 = xv1; cv2 = xv2; cv3 = xv3;
#pragma unroll
        for (int c = 0; c < 4; ++c) { b0[c] = BLD128(urs, cv0 + (unsigned)(c * 256), 0); __builtin_amdgcn_sched_barrier(0); b0[4 + c] = BLD128(urs, cv1 + (unsigned)(c * 256), 0); __builtin_amdgcn_sched_barrier(0); }
        while (clive) {
            U_BLOADS(b1, cv2, cv3);
            __builtin_amdgcn_sched_barrier(0);
            const int rw = cent >= 0 ? (cent & 0xffff) : 0, slot = cent >= 0 ? (cent >> 16) : 0;
            const float us = US[rw], vs = VS[rw], gate = PGATE[(size_t)cR * 128 + slot];
            f32x4 a0 = {0.f, 0.f, 0.f, 0.f}, a1 = {0.f, 0.f, 0.f, 0.f}, a2 = {0.f, 0.f, 0.f, 0.f}, a3 = {0.f, 0.f, 0.f, 0.f};
            U_MFMA(b0, cpar * 2048, a0, a1);
            U_SETUP();
            U_BLOADS(b0, xlive ? xv0 : OOB, xlive ? xv1 : OOB);
            __builtin_amdgcn_sched_barrier(0);
            U_MFMA(b1, cpar * 2048, a2, a3);
            asm volatile("s_nop 15\n\ts_nop 15" ::: "memory");
            {
              const f32x4 aq = e4 == 0 ? a0 : (e4 == 1 ? a1 : (e4 == 2 ? a2 : a3));
              float w = sl4 == 0 ? aq.x : (sl4 == 1 ? aq.y : (sl4 == 2 ? aq.z : aq.w));
              w += __shfl_xor(w, 1); w += __shfl_xor(w, 2);
              if (cent >= 0) {
                const float av = gelu_erf(w * us * chs) * gate * vs;
                ACT[(size_t)cR * 128 + (slot & 7) * 16 + (slot >> 3)] = (pk2(0.f, av) & 0xffff0000u) | (unsigned)rw; } }
            clive = xlive; cR = xR; cpar = xpar; cent = xent; chs = xhs; cv0 = xv0; cv1 = xv1; cv2 = xv2; cv3 = xv3;
        }
#undef U_VO
#undef U_SETUP
#undef U_BLOADS
#undef U_MFMA
    }
}
typedef float f32x2v __attribute__((ext_vector_type(2)));
constexpr int NGRP_V = 8;
struct PvMeta { int R; v4u m[4]; };
__device__ __forceinline__ PvMeta pv_meta(const Args& A, int l, int t, int ntok, int lane) {
    PvMeta M; const int tt = t < ntok ? t : 0; M.R = peer_row(l, tt);
    const v4u* mp = (const v4u*)((const unsigned*)(A.ws + WS_ACT) + (size_t)M.R * 128 + (lane >> 3) * 16);
#pragma unroll
    for (int q = 0; q < 4; ++q) M.m[q] = mp[q];
    return M;
}
#define PV_W(M, i) ((i) & 3) == 0 ? M.m[(i) >> 2].x : (((i) & 3) == 1 ? M.m[(i) >> 2].y : (((i) & 3) == 2 ? M.m[(i) >> 2].z : M.m[(i) >> 2].w))
#define PV_LOADS(W, M) do { _Pragma("unroll") for (int i = 0; i < 16; ++i) { const unsigned mw = PV_W(M, i); W[i] = BLD128(vrs, ((mw & amv) << 10) + lane16, soff); } } while (0)
typedef int i32x2v __attribute__((ext_vector_type(2)));
template <int OFF> __device__ __forceinline__ i32x2v tr4_read(int addr) {
    i32x2v r; asm volatile("ds_read_b64_tr_b4 %0, %1 offset:%2" : "=&v"(r) : "v"(addr), "i"(OFF) : "memory"); return r; }
__device__ __forceinline__ f32x4 pv_res_x(const Args& A, int R, int s, int lane) {
    const int col = s * 256 + lane * 4;
    const f32x2 w2 = *(const f32x2*)((const bf16*)(A.ws + WS_XS) + (size_t)R * 2048 + col); const unsigned wa = __float_as_uint(w2.x), wb = __float_as_uint(w2.y);
    return (f32x4){bflo(wa), bfhi(wa), bflo(wb), bfhi(wb)};
}
struct PvAct { v4u w[8]; };
__device__ __forceinline__ PvAct pv_act_load(const Args& A, int R, int lane) {
    PvAct P; const v4u* ap = (const v4u*)((const unsigned*)(A.ws + WS_ACT) + (size_t)R * 128 + (lane >> 4) * 32);
#pragma unroll
    for (int q = 0; q < 8; ++q) P.w[q] = ap[q];
    return P;
}
__device__ __forceinline__ i32x8v pv_act_operand(const PvAct& P, int lane, bool en, float* inv) {
    unsigned mx = 0u;
#pragma unroll
    for (int q = 0; q < 8; ++q) { mx = max(mx, P.w[q].x & 0x7fff0000u); mx = max(mx, P.w[q].y & 0x7fff0000u); mx = max(mx, P.w[q].z & 0x7fff0000u); mx = max(mx, P.w[q].w & 0x7fff0000u); }
    mx = max(mx, (unsigned)__shfl_xor((int)mx, 16)); mx = max(mx, (unsigned)__shfl_xor((int)mx, 32));
    int E = (int)(mx >> 23); E = E < 24 ? 24 : (E > 230 ? 230 : E);
    *inv = __uint_as_float((unsigned)(E - 7) << 23);
    const float S = en ? __uint_as_float((unsigned)(261 - E) << 23) : 0.f;
    const int row = lane & 15; int o[8];
#pragma unroll
    for (int q = 0; q < 8; ++q) { const float a0 = __uint_as_float(P.w[q].x & 0xffff0000u) * S, a1 = __uint_as_float(P.w[q].y & 0xffff0000u) * S, a2 = __uint_as_float(P.w[q].z & 0xffff0000u) * S, a3 = __uint_as_float(P.w[q].w & 0xffff0000u) * S;
        const int q1 = (int)f8x4(a0, a1, a2, a3);
        const f32x2v b01 = __builtin_amdgcn_cvt_pk_f32_fp8(q1, false), b23 = __builtin_amdgcn_cvt_pk_f32_fp8(q1, true);
        const int q2 = (int)f8x4(a0 - b01.x, a1 - b01.y, a2 - b23.x, a3 - b23.y);
        o[q] = row == 0 ? q1 : (row == 1 ? q2 : 0); }
    return (i32x8v){o[0], o[1], o[2], o[3], o[4], o[5], o[6], o[7]};
}
__device__ __forceinline__ PvMeta pv_meta_lds(const LAS unsigned char* ab, int R, int lane) { PvMeta M; M.R = R;
#pragma unroll
    for (int q = 0; q < 4; ++q) M.m[q] = *(const LAS v4u*)(ab + (lane >> 3) * 64 + q * 16);
    return M; }
__device__ __forceinline__ PvAct pv_act_lds(const LAS unsigned char* ab, int lane) { PvAct P;
#pragma unroll
    for (int q = 0; q < 8; ++q) P.w[q] = *(const LAS v4u*)(ab + (lane >> 4) * 128 + q * 16);
    return P; }
__device__ __forceinline__ void phase_peer_v(const Args& A, const Frame& F0, int l, int pmode = 0) {
    const Frame F = refresh(F0);
    const unsigned amv = pmode == 1 ? 63u : 0xffffu;
    const int lane = F.lane;
    const int nvx = F.pnx, vx = F.px, rank = F.prank, nrank = F.pcnt;
    const int ntok = l == 0 ? MROWS : NB * SEQL;
    const unsigned char* V4 = (const unsigned char*)(A.ws + WS_V8) + (size_t)l * NEXP * 1024;
    const rsrc_t vrs = mk_rsrc(V4, (unsigned)NEXP * 1024u); const unsigned lane16 = (unsigned)(lane & 7) * 16u;
    const int stride = nrank * NWAVES, t0 = rank * NWAVES + F.wave;
    const bool en = (DBG & (l == 0 ? 8 : 32)) != 0;
    const int g = lane >> 3, c = lane & 7, j = lane & 15, kg = lane >> 4;
    LAS unsigned char* tl = F.lds + F.wave * 16384;
    const int tile = (int)(uintptr_t)(F.ldsg + F.wave * 16384);
    int wbs[8], rbs[8];
#pragma unroll
    for (int k = 0; k < 8; ++k) { wbs[k] = ((g & 1) * 64 + (g >> 1) * 16) * 128 + ((c ^ k) * 16); rbs[k] = tile + (32 * kg + j) * 128 + ((k ^ ((j >> 1) & 7)) * 16); }
    int sc1 = 127; asm volatile("" : "+v"(sc1));
    for (int s = vx; s < NGRP_V; s += nvx) {
        const int soff = __builtin_amdgcn_readfirstlane(s * 128);
        const unsigned* ACTp = (const unsigned*)(A.ws + WS_ACT);
#define PV_RAW(t_) (*(const f32x2*)(ACTp + (size_t)peer_row(l, (t_) < ntok ? (t_) : 0) * 128 + lane * 2))
        LAS unsigned char* ab = F.lds + RING_BYTES + 1024 + F.wave * 1024;
        { const f32x2 r0 = PV_RAW(t0), r1 = PV_RAW(t0 + stride); *(LAS f32x2*)(ab + lane * 8) = r0; *(LAS f32x2*)(ab + 512 + lane * 8) = r1; }
        f32x2 rawn = PV_RAW(t0 + 2 * stride);
        PvMeta mc = pv_meta_lds(ab, peer_row(l, t0 < ntok ? t0 : 0), lane), mn = pv_meta_lds(ab + 512, peer_row(l, t0 + stride < ntok ? t0 + stride : 0), lane);
        v4u W[16];
        float invc; i32x8v aop = pv_act_operand(pv_act_lds(ab, lane), lane, en, &invc);
        PV_LOADS(W, mc);
        int cR = mc.R, par = 0, gmrow = -1; f32x4 ggc = {0.f, 0.f, 0.f, 0.f};
        for (int t = t0; t < ntok; t += stride) {
#pragma unroll
            for (int i = 0; i < 16; ++i) { *(LAS v4u*)(tl + wbs[(i >> 1) & 7] + i * 128) = W[i]; const unsigned mw = PV_W(mn, i); W[i] = BLD128(vrs, ((mw & amv) << 10) + lane16, soff); }
            const f32x4 prx = pv_res_x(A, cR, s, lane);
            { const int tp_ = cR % TPB, mrow = tp_ < CTXL ? 8 : cR / TPB;
              if (mrow != gmrow) { gmrow = mrow; ggc = *(const f32x4*)((const float*)(A.ws + WS_MOD) + (size_t)(l * 9 + mrow) * 12288 + 5 * 2048 + s * 256 + lane * 4); } }
            __builtin_amdgcn_sched_barrier(0);
            asm volatile("s_waitcnt lgkmcnt(0)" ::: "memory");
            float res[16];
#define PV_TR(B_, gq_) do { _Pragma("unroll") for (int q_ = 0; q_ < 4; ++q_) { constexpr int dummy_ = 0; (void)dummy_; } \
                B_[0] = tr4_read<((4 * (gq_) + 0) & 1) * 8>(rbs[(4 * (gq_) + 0) >> 1]); B_[1] = tr4_read<2048 + ((4 * (gq_) + 0) & 1) * 8>(rbs[(4 * (gq_) + 0) >> 1]); \
                B_[2] = tr4_read<((4 * (gq_) + 1) & 1) * 8>(rbs[(4 * (gq_) + 1) >> 1]); B_[3] = tr4_read<2048 + ((4 * (gq_) + 1) & 1) * 8>(rbs[(4 * (gq_) + 1) >> 1]); \
                B_[4] = tr4_read<((4 * (gq_) + 2) & 1) * 8>(rbs[(4 * (gq_) + 2) >> 1]); B_[5] = tr4_read<2048 + ((4 * (gq_) + 2) & 1) * 8>(rbs[(4 * (gq_) + 2) >> 1]); \
                B_[6] = tr4_read<((4 * (gq_) + 3) & 1) * 8>(rbs[(4 * (gq_) + 3) >> 1]); B_[7] = tr4_read<2048 + ((4 * (gq_) + 3) & 1) * 8>(rbs[(4 * (gq_) + 3) >> 1]); } while (0)
#define PV_MM4(B_, D_) do { _Pragma("unroll") for (int q_ = 0; q_ < 4; ++q_) { const i32x4v bop_ = {B_[2 * q_].x, B_[2 * q_].y, B_[2 * q_ + 1].x, B_[2 * q_ + 1].y}; \
                asm volatile("v_mfma_scale_f32_16x16x128_f8f6f4 %0, %1, %2, 0, %3, %4 op_sel_hi:[0,0,0] blgp:4" : "=&v"(D_[q_]) : "v"(aop), "v"(bop_), "v"(sc1), "v"(sc1)); } } while (0)
#define PV_RES(D_, gq_) do { _Pragma("unroll") for (int q_ = 0; q_ < 4; ++q_) res[4 * (gq_) + q_] = D_[q_].x + D_[q_].y; } while (0)
            { i32x2v ba[8], bb[8]; f32x4 da[4], db[4];
              PV_TR(ba, 0);
              PV_TR(bb, 1); asm volatile("s_waitcnt lgkmcnt(8)" ::: "memory"); PV_MM4(ba, da);
              PV_TR(ba, 2); asm volatile("s_waitcnt lgkmcnt(8)" ::: "memory"); PV_MM4(bb, db); asm volatile("s_nop 7" ::: "memory"); PV_RES(da, 0);
              PV_TR(bb, 3); asm volatile("s_waitcnt lgkmcnt(8)" ::: "memory"); PV_MM4(ba, da); asm volatile("s_nop 7" ::: "memory"); PV_RES(db, 1);
              asm volatile("s_waitcnt lgkmcnt(0)" ::: "memory"); PV_MM4(bb, db); asm volatile("s_nop 7" ::: "memory"); PV_RES(da, 2);
              asm volatile("s_nop 15\n\ts_nop 7" ::: "memory"); PV_RES(db, 3); }
#undef PV_TR
#undef PV_MM4
#undef PV_RES
            if (lane < 16) {
#pragma unroll
                for (int nb = 0; nb < 16; ++nb) ((LAS float*)tl)[nb * 16 + j] = res[nb]; }
            asm volatile("s_waitcnt lgkmcnt(0)" ::: "memory");
            const f32x4 ov = *(const LAS f32x4*)(tl + lane * 16);
            asm volatile("s_waitcnt lgkmcnt(0)" ::: "memory");
            { const int R = cR, b = R / TPB, tp = R % TPB; const int col = s * 256 + lane * 4;
              f32x4 xo = {prx.x + ggc.x * (ov.x * invc), prx.y + ggc.y * (ov.y * invc), prx.z + ggc.z * (ov.z * invc), prx.w + ggc.w * (ov.w * invc)};
#if DBG_CHECK
              if (l == 1) { const float cs_ = 1.f + chk_code(A); xo = xo * cs_; }
#endif
              if (l == 0) { f32x2 o2; o2.x = __uint_as_float(pk2(xo.x, xo.y)); o2.y = __uint_as_float(pk2(xo.z, xo.w)); *(f32x2*)((bf16*)(A.ws + WS_XS) + (size_t)R * 2048 + col) = o2; }
              else *(f32x4*)(A.out + (size_t)(b * SEQL + tp - CTXL) * 2048 + col) = xo; }
            aop = pv_act_operand(pv_act_lds(ab + (par ^ 1) * 512, lane), lane, en, &invc);
            cR = mn.R;
            *(LAS f32x2*)(ab + par * 512 + lane * 8) = rawn;
            mn = pv_meta_lds(ab + par * 512, peer_row(l, t + 2 * stride < ntok ? t + 2 * stride : 0), lane);
            rawn = PV_RAW(t + 3 * stride);
            par ^= 1;
        }
#undef PV_RAW
    }
}

constexpr int N_PHASES = 24;
__global__ void __launch_bounds__(NTHR, 2) mega_fwd(Args args) {
    extern __shared__ __attribute__((aligned(16))) unsigned char lds[];
    Frame F;
    F.lds = (LAS unsigned char*)lds; F.ldsg = lds;
    F.tid = threadIdx.x; F.lane = F.tid & 63; F.wave = __builtin_amdgcn_readfirstlane(F.tid >> 6);
    F.G = gridDim.x; { const int bx = blockIdx.x; F.vcu = (F.G % 8 == 0) ? (bx % 8) * (F.G / 8) + bx / 8 : bx; }
    for (int u = F.tid; u < (LDS_BYTES - LDSCTL_OFF) / 4; u += NTHR) ((LAS unsigned*)(F.lds + LDSCTL_OFF))[u] = 0u;
    __syncthreads();
    volatile LAS unsigned* MISC = (volatile LAS unsigned*)(F.lds + MISC_OFF);
    XcdBarrier bar = xcd_barrier_post((unsigned*)(args.ws + WS_CTL) + CW_BAR + args.li * XCD_BAR_WORDS, MISC + 8);
    unsigned char* ws = args.ws;
    const int lo = args.ph_lo, hi = args.ph_hi;
    { const int nvx_ = (F.G % 8 == 0) ? 8 : 1; F.pnx = nvx_; F.px = (int)blockIdx.x % nvx_; F.prank = (int)blockIdx.x / nvx_; F.pcnt = F.G / nvx_; }
#define PH(k) (lo <= (k) && (k) < hi)
#define SEAM(k) do { if (PH(k) && PH((k) + 1)) xcd_barrier(bar); } while (0)
#ifndef REP_MASK
#define REP_MASK 0
#endif
#ifndef PROBE_P
#define PROBE_P 1
#endif
#ifndef PROBE_B
#define PROBE_B 0
#endif
#ifndef PROBE_E
#define PROBE_E 1
#endif
#ifndef PROBE_K
#define PROBE_K 1024
#endif
#ifndef PROBE_A
#define PROBE_A 2
#endif
#ifndef PROBE_U
#define PROBE_U 0
#endif
#define NREP(bit) ((REP_MASK >> (bit)) & 1 ? 2 : 1)
#define REPEAT(bit) for (int rep_ = 0; rep_ < NREP(bit); ++rep_)
#define FILLER(S, j0, j1) do { const int rounds_ = ((S).total + F.G - 1) / F.G, nb_ = (S).total - (rounds_ - 1) * F.G, c_ = (int)blockIdx.x; \
    if (nb_ >= F.G) quant_fill(args, F, j0, j1, c_, F.G); else if (c_ >= nb_) quant_fill(args, F, j0, j1, c_ - nb_, F.G - nb_); } while (0)
    REPEAT(0) { if (PH(0)) phase_prologue(args, F, (NREP(0) == 2 && rep_ == 0) ? PROBE_P : 0);
    SEAM(0); }
    if (PH(1)) phase_rownorm(args, F, 0, 0, true);
    SEAM(1);
    for (int xb_ = 0; xb_ < PROBE_B; ++xb_) xcd_barrier(bar);
    for (int l = 0; l < 2; ++l) {
        const int pb = 2 + 11 * l;
        REPEAT(1) {
        if (PH(pb + 0)) { pg8::Gemm g{(const pg8::bf16_t*)(ws + WS_HN), (const pg8::bf16_t*)(ws + WS_WIN + (size_t)l * 4608 * 2048), MROWS, INC, (NREP(1) == 2 && rep_ == 0) ? PROBE_K : 1024};
          pg8::SegOrder S; if (l == 0) S.init(F.G, (int)blockIdx.x, 0, 0, 18, 2, 9, 0); else S.init(F.G, (int)blockIdx.x, 1, 0, 18, 2, 9, 9);
          pg8::EpiQKV E{(pg8::bf16_t*)(ws + WS_QKV), (NREP(1) == 2 && rep_ == 0 && PROBE_E) ? nullptr : (const float*)(ws + WS_GAINS) + l * 512, (const float*)(ws + WS_ROPE), (PG8_LAS float*)(F.lds + RING_BYTES + 1024)};
          pg8::gemm_phase<pg8::EpiQKV, pg8::SegOrder, true, true, true>(F.lds, g, S, E, F.wave);
          if (l == 0 && rep_ == 0) { FILLER(S, 0, 21000); } }
        SEAM(pb + 0); }
        REPEAT(2) { if (PH(pb + 2)) phase_attention(args, F, l, (NREP(2) == 2 && rep_ == 0) ? PROBE_A : 7);
        SEAM(pb + 2); }
        REPEAT(8) { if (PH(pb + 3)) phase_retention_out(args, F, l);
        SEAM(pb + 3); }
        for (int rep_ = 0; rep_ < (l == 0 ? NREP(3) : 1); ++rep_) {
        if (PH(pb + 4)) { pg8::Gemm g{(const pg8::bf16_t*)(ws + WS_CAT), (const pg8::bf16_t*)(ws + WS_WOUT + (size_t)l * 2048 * 2048), MROWS, 2048, 1024};
          pg8::SegOrder S; S.init(F.G, (int)blockIdx.x, l == 0 ? 0 : 1, 0, 8, 2, 0, 0);
          pg8::EpiResid E{l == 0 ? args.in[IN_X] : nullptr, args.in[IN_CTX], (pg8::bf16_t*)(ws + WS_XS), (const float*)(ws + WS_MOD) + (size_t)l * 9 * 12288 + 2 * 2048, (l == 1 && !(DBG & 16)) ? 0.f : 1.f};
          pg8::gemm_phase<pg8::EpiResid, pg8::SegOrder, true, true, true>(F.lds, g, S, E, F.wave);
          if (l == 0 && rep_ == 0) { FILLER(S, 21000, 43800); } }
        SEAM(pb + 4); }
        REPEAT(9) { if (PH(pb + 5)) phase_rownorm(args, F, l, 1, l == 0);
        SEAM(pb + 5); }
        REPEAT(4) {
        if (PH(pb + 6)) { pg8::Gemm g{(const pg8::bf16_t*)(ws + WS_HN), (const pg8::bf16_t*)(ws + WS_WPQ) + (size_t)l * 2048 * 2048, MROWS, 2048, 2048};
          pg8::SegOrder S; S.init(F.G, (int)blockIdx.x, l == 0 ? 0 : 1, 0, 8, 2, 0, 0);
          pg8::EpiQP E{(pg8::bf16_t*)(ws + WS_QKV)};
          pg8::gemm_phase<pg8::EpiQP, pg8::SegOrder, true, true, false>(F.lds, g, S, E, F.wave);
          if (l == 0 && rep_ == 0) { FILLER(S, 43800, 65536); } }
        SEAM(pb + 6); }
        REPEAT(7) { if (PH(pb + 7)) phase_peer_topk(args, F, l);
        SEAM(pb + 7); }
        REPEAT(5) { if (PH(pb + 8)) phase_peer_u(args, F, l, (NREP(5) == 2 && rep_ == 0) ? PROBE_U : 0);
        SEAM(pb + 8); }
        for (int rep_ = 0; rep_ < (l == 1 ? NREP(6) : 1); ++rep_) { if (PH(pb + 9)) phase_peer_v(args, F, l, (l == 1 && NREP(6) == 2 && rep_ == 0) ? PROBE_U : 0);
        if (rep_ + 1 < (l == 1 ? NREP(6) : 1)) xcd_barrier(bar); }
        SEAM(pb + 9);
        if (PH(pb + 10) && l == 0) phase_rownorm(args, F, 1, 2, true);
        SEAM(pb + 10);
    }
#undef PH
#undef SEAM
}
#if DBG_CHECK
__global__ void __launch_bounds__(NTHR) chk_kernel(Args args, int which) {
    if (which == 0) { chk_save(args, threadIdx.x); __syncthreads(); __threadfence(); chk_qp_topk(args, threadIdx.x); }
    else chk_experts(args, threadIdx.x);
}
#endif

extern "C" void kernel_launch(void* const* d_in, const int* in_sizes, int n_in, void* d_out, int out_size, void* d_ws, size_t ws_size, hipStream_t stream) {
    static int grid = 0;
    if (grid == 0) {
        if (n_in != 22 || ws_size < WS_END) { fprintf(stderr, "kernel_launch: unexpected n_in %d / ws_size %zu (need %zu)\n", n_in, ws_size, (size_t)WS_END); grid = -1; return; }
        int dev = 0, cus = 0, per_cu = 0;
        (void)hipGetDevice(&dev);
        (void)hipDeviceGetAttribute(&cus, hipDeviceAttributeMultiprocessorCount, dev);
        if (hipFuncSetAttribute((const void*)mega_fwd, hipFuncAttributeMaxDynamicSharedMemorySize, LDS_BYTES) != hipSuccess) { fprintf(stderr, "kernel_launch: hipFuncSetAttribute failed\n"); grid = -1; return; }
        (void)hipOccupancyMaxActiveBlocksPerMultiprocessor(&per_cu, (const void*)mega_fwd, NTHR, LDS_BYTES);
        (void)hipGetLastError();
        if (per_cu < 1) fprintf(stderr, "kernel_launch: occupancy query says %d blocks per CU\n", per_cu);
        grid = cus > 0 ? cus : 256;
    }
    if (grid < 0) return;
    (void)hipMemsetAsync((char*)d_ws + WS_CTL, 0, CTL_ZERO_BYTES, stream);
    Args a{};
    for (int i = 0; i < 22; ++i) a.in[i] = (const float*)d_in[i];
    a.out = (float*)d_out; a.ws = (unsigned char*)d_ws;
#if DBG_CHECK
    const int cuts[4] = {0, 10, 12, N_PHASES};
    for (int li = 0; li < 3; ++li) {
        a.ph_lo = cuts[li]; a.ph_hi = cuts[li + 1]; a.li = li;
        void* kargs[] = {&a};
        hipError_t e = hipLaunchCooperativeKernel((const void*)mega_fwd, dim3(grid), dim3(NTHR), kargs, LDS_BYTES, stream);
        if (e != hipSuccess) fprintf(stderr, "kernel_launch: cooperative launch failed: %s (grid %d)\n", hipGetErrorString(e), grid);
        if (li < 2) hipLaunchKernelGGL(chk_kernel, dim3(1), dim3(NTHR), 0, stream, a, li);
    }
#else
    a.ph_lo = 0; a.ph_hi = N_PHASES; a.li = 0;
    void* kargs[] = {&a};
    hipError_t e = hipLaunchCooperativeKernel((const void*)mega_fwd, dim3(grid), dim3(NTHR), kargs, LDS_BYTES, stream);
    if (e != hipSuccess) fprintf(stderr, "kernel_launch: cooperative launch failed: %s (grid %d)\n", hipGetErrorString(e), grid);
#endif
}
```

```cpp
#include <hip/hip_runtime.h>
#include <hip/hip_bf16.h>
#include <cstdio>
#include <cstdint>
#include <cmath>

namespace pg8 {
#define PG8_LAS __attribute__((address_space(3)))
typedef unsigned short bf16_t;
typedef short bf16x8 __attribute__((ext_vector_type(8)));
typedef float f32x4 __attribute__((ext_vector_type(4)));
typedef unsigned u32x4 __attribute__((ext_vector_type(4)));
constexpr int BM = 256, BK = 64, HALF = 128, HTB = HALF * BK * 2  , STAGE_BYTES = 8 * HTB, NXCD = 8, WGM = 8;

__host__ __device__ __forceinline__ int lds_byte(int r, int c) { const int st = (r >> 4) * 2 + (c >> 5), rr = r & 15, cc = c & 31, ob = rr * 64 + cc * 2; return st * 1024 + (ob ^ (((ob >> 9) & 1) << 5)); }
__host__ __device__ __forceinline__ void stage_rc(int b, int& R, int& C) { const int st = b / 1024, sb = b % 1024, swz = sb ^ (((sb >> 9) & 1) << 5); R = (st >> 1) * 16 + swz / 64; C = (st & 1) * 32 + (swz % 64) / 2; }
__host__ __device__ __forceinline__ int perm32(int rho) { const int n = rho >> 4, i = rho & 15; return 8 * (i >> 2) + 4 * n + (i & 3); }

struct Unit { int pm, pn; };
struct Gemm { const bf16_t* A; const bf16_t* Bt; int M, N, K; };

struct StaticOrder {
    int nM, nN, nwg, G, c;
    __host__ __device__ void init(int M, int N, int G_, int c_) { nM = M / BM; nN = N / BM; nwg = nM * nN; G = G_; c = c_; }
    __host__ __device__ bool next(int i, Unit& u) const {
        const long L = (long)i * G + c; if (L >= nwg) return false;
        int wgid = (int)L; { const int q = nwg / NXCD, r = nwg % NXCD, xcd = wgid % NXCD, off = wgid / NXCD; wgid = (xcd < r ? xcd * (q + 1) : r * (q + 1) + (xcd - r) * q) + off; }
        const int nig = WGM * nN, gid = wgid / nig, fm = gid * WGM, gsz = (nM - fm) < WGM ? (nM - fm) : WGM;
        u.pm = fm + ((wgid % nig) % gsz); u.pn = (wgid % nig) / gsz; return true;
    }
    __device__ __forceinline__ void a_ready(const Unit&) const {}
    __device__ __forceinline__ void done(const Unit&) const {}
};

__device__ __forceinline__ unsigned cvt_pk_bf16(float lo, float hi) { unsigned r; asm volatile("v_cvt_pk_bf16_f32 %0, %1, %2" : "=v"(r) : "v"(lo), "v"(hi)); return r; }
typedef float f32x2 __attribute__((ext_vector_type(2)));
__device__ __forceinline__ f32x2 gelu_pk(f32x2 v) {
    const f32x2 av = __builtin_elementwise_abs(v), d = av * 0.2316418882f + 1.0f;
    f32x2 t; t.x = __builtin_amdgcn_rcpf(d.x); t.y = __builtin_amdgcn_rcpf(d.y);
    f32x2 q = t * 0.5307027145f + (-0.7265760135f); q = q * t + 0.7107068705f; q = q * t + (-0.142248368f); q = q * t + 0.127414796f; q = q * t;
    const f32x2 s = (v * v) * (-0.72134752044f);
    f32x2 e; e.x = __builtin_amdgcn_exp2f(s.x); e.y = __builtin_amdgcn_exp2f(s.y);
    const f32x2 m = v * (q * e), r = v - m;
    f32x2 o; o.x = v.x < 0.f ? m.x : r.x; o.y = v.y < 0.f ? m.y : r.y; return o;
}

template <int ACT  > struct EpiBf16 {
    static constexpr bool PERM = true, AFTER_DRAIN = false; static_assert(ACT == 0 || ACT == 1, "EpiBf16: ACT is 0 (none) or 1 (gelu_pk)");
    bf16_t* O; int ldc; const float* bias; int split_cols; size_t split_stride; float scale0;
    __device__ __forceinline__ void operator()(const f32x4 (&acc)[2][2][4][2], const Unit& u, int wr, int wc, int fr, int fq) const {
        const int row0 = u.pm * BM + wr * 64 + fr; int colt = u.pn * BM; bf16_t* base = O;
        float sc = 1.f; if (split_cols) { const int t = colt / split_cols; base += (size_t)t * split_stride; colt -= t * split_cols; if (t == 0) sc = scale0; }
        const int col0 = colt + wc * 32 + 8 * fq, bcol0 = u.pn * BM + wc * 32 + 8 * fq;
        f32x4 bv[2][2];
#pragma unroll
        for (int bj = 0; bj < 2; ++bj)
#pragma unroll
            for (int n = 0; n < 2; ++n) bv[bj][n] = bias ? *(const f32x4*)(bias + bcol0 + bj * HALF + 4 * n) : (f32x4){0.f, 0.f, 0.f, 0.f};
#pragma unroll
        for (int ai = 0; ai < 2; ++ai)
#pragma unroll
            for (int m = 0; m < 4; ++m) { bf16_t* rowp = base + (size_t)(row0 + ai * HALF + m * 16) * ldc + col0;
#pragma unroll
                for (int bj = 0; bj < 2; ++bj) { f32x4 v0 = acc[ai][bj][m][0] + bv[bj][0], v1 = acc[ai][bj][m][1] + bv[bj][1];
                    if (ACT == 1) { f32x2 a = gelu_pk((f32x2){v0[0], v0[1]}), b = gelu_pk((f32x2){v0[2], v0[3]}), c = gelu_pk((f32x2){v1[0], v1[1]}), d = gelu_pk((f32x2){v1[2], v1[3]});
                        v0 = (f32x4){a.x, a.y, b.x, b.y}; v1 = (f32x4){c.x, c.y, d.x, d.y}; }
                    v0 = v0 * sc; v1 = v1 * sc; u32x4 w; w.x = cvt_pk_bf16(v0[0], v0[1]); w.y = cvt_pk_bf16(v0[2], v0[3]); w.z = cvt_pk_bf16(v1[0], v1[1]); w.w = cvt_pk_bf16(v1[2], v1[3]);
                    *(u32x4*)(rowp + bj * HALF) = w; } }
    }
};
template <class Epi, class Sched, bool ALIGN_EPI = false, bool SP2 = false, bool F8 = false>
__device__ __forceinline__ void gemm_phase(PG8_LAS unsigned char* lds, const Gemm g, const Sched& S, const Epi& E, int wave_id) {
    typedef int i32x4_t __attribute__((ext_vector_type(4))); typedef int i32x8_t __attribute__((ext_vector_type(8)));
    int tid; { int l_; asm volatile("v_mbcnt_lo_u32_b32 %0, -1, 0\n\tv_mbcnt_hi_u32_b32 %0, -1, %0" : "=v"(l_)); tid = wave_id * 64 + l_; }
    const int wid = __builtin_amdgcn_readfirstlane(tid >> 6), lane = tid & 63, wr = wid >> 2, wc = wid & 3, fr = lane & 15, fq = lane >> 4;
    const int K = g.K, nt = K / BK;
    unsigned voffA[2], voffB[2];
#pragma unroll
    for (int i = 0; i < 2; ++i) { int R, C; stage_rc(tid * 16 + i * 8192, R, C); const int Rb = Epi::PERM ? ((R & ~31) + perm32(R & 31)) : R;
        voffA[i] = (unsigned)(R * K + C) * 2u; voffB[i] = (unsigned)(Rb * K + C) * 2u; }
    const size_t kstep = (size_t)(BK * 2);
    const size_t hstep = (size_t)HALF * K * 2;
    const size_t tstep = 2 * hstep;
    const unsigned ldsw = (unsigned)wid * 1024u;
    const int aoff = lds_byte(wr * 64 + fr, fq * 8), boff = lds_byte(wc * 32 + fr, fq * 8);
#define PG8_SA(b, h) (((b) * 2 + (h)) * HTB)
#define PG8_SB(b, h) ((4 + (b) * 2 + (h)) * HTB)
#define PG8_STAGE(bufoff, gbase, voff) do { _Pragma("unroll") for (int _i = 0; _i < 2; ++_i) \
        __builtin_amdgcn_global_load_lds((const unsigned*)((const char*)(gbase) + (voff)[_i]), (PG8_LAS unsigned*)(lds + (bufoff) + ldsw + _i * 8192), 16, 0, 0); } while (0)
#define PG8_LDA(dst, b, h) do { if constexpr (F8) { _Pragma("unroll") for (int m = 0; m < 4; ++m) { const i32x4_t lo_ = *(const PG8_LAS i32x4_t*)(lds + PG8_SA(b, h) + aoff + m * 2048), hi_ = *(const PG8_LAS i32x4_t*)(lds + PG8_SA(b, h) + aoff + m * 2048 + 1024); dst##8[m] = __builtin_shufflevector(lo_, hi_, 0, 1, 2, 3, 4, 5, 6, 7); } } \
    else { _Pragma("unroll") for (int m = 0; m < 4; ++m) _Pragma("unroll") for (int k = 0; k < 2; ++k) dst[m][k] = *(const PG8_LAS bf16x8*)(lds + PG8_SA(b, h) + aoff + m * 2048 + k * 1024); } } while (0)
#define PG8_LDB(dst, b, h) do { if constexpr (F8) { _Pragma("unroll") for (int n = 0; n < 2; ++n) { const i32x4_t lo_ = *(const PG8_LAS i32x4_t*)(lds + PG8_SB(b, h) + boff + n * 2048), hi_ = *(const PG8_LAS i32x4_t*)(lds + PG8_SB(b, h) + boff + n * 2048 + 1024); dst##8[n] = __builtin_shufflevector(lo_, hi_, 0, 1, 2, 3, 4, 5, 6, 7); } } \
    else { _Pragma("unroll") for (int n = 0; n < 2; ++n) _Pragma("unroll") for (int k = 0; k < 2; ++k) dst[n][k] = *(const PG8_LAS bf16x8*)(lds + PG8_SB(b, h) + boff + n * 2048 + k * 1024); } } while (0)
#define PG8_MMA(ai, bj, At, Bt) do { __builtin_amdgcn_s_setprio(1); \
        if constexpr (F8) {   \
            _Pragma("unroll") for (int m = 0; m < 4; ++m) _Pragma("unroll") for (int n = 0; n < 2; ++n) \
                asm volatile("v_mfma_scale_f32_16x16x128_f8f6f4 %0, %1, %2, %0, %3, %4 op_sel_hi:[0,0,0]" : "+v"(acc[ai][bj][m][n]) : "v"(Bt##8[n]), "v"(At##8[m]), "v"(f8sa), "v"(f8sb));   \
        } else { _Pragma("unroll") for (int m = 0; m < 4; ++m) _Pragma("unroll") for (int n = 0; n < 2; ++n) _Pragma("unroll") for (int k = 0; k < 2; ++k) \
        acc[ai][bj][m][n] = __builtin_amdgcn_mfma_f32_16x16x32_bf16(Bt[n][k], At[m][k], acc[ai][bj][m][n], 0, 0, 0); } __builtin_amdgcn_s_setprio(0); } while (0)
#define PG8_WAIT_V(n) asm volatile("s_waitcnt vmcnt(" #n ")" ::: "memory")
#define PG8_WAIT_L(n) asm volatile("s_waitcnt lgkmcnt(" #n ")" ::: "memory")
#define PG8_BAR __builtin_amdgcn_s_barrier()
#define PG8_SCHED __builtin_amdgcn_sched_barrier(0)
    Unit cur, nxt; int ui = 0;
    if (!S.next(0, cur)) return;
    f32x4 acc[2][2][4][2];
#pragma unroll
    for (int a = 0; a < 2; ++a)
#pragma unroll
        for (int b = 0; b < 2; ++b)
#pragma unroll
            for (int m = 0; m < 4; ++m)
#pragma unroll
                for (int n = 0; n < 2; ++n) acc[a][b][m][n] = (f32x4){0.f, 0.f, 0.f, 0.f};
    bf16x8 At[4][2], B0[2][2], B1[2][2]; i32x8_t At8[4], B08[2], B18[2];
    int f8sa = 121, f8sb = 127; asm volatile("" : "+v"(f8sa), "+v"(f8sb));
    const char* cA = (const char*)g.A + (size_t)cur.pm * tstep; const char* cB = (const char*)g.Bt + (size_t)cur.pn * tstep;
    S.a_ready(cur);
    if constexpr (SP2) {
        PG8_STAGE(PG8_SB(0, 0), cB, voffB); PG8_STAGE(PG8_SB(0, 1), cB + hstep, voffB); PG8_STAGE(PG8_SA(0, 0), cA, voffA); PG8_STAGE(PG8_SA(0, 1), cA + hstep, voffA);
        if (wr == 1) PG8_BAR;
        PG8_WAIT_V(2); PG8_BAR;
        PG8_STAGE(PG8_SB(1, 0), cB + kstep, voffB); PG8_STAGE(PG8_SA(1, 0), cA + kstep, voffA); PG8_STAGE(PG8_SB(1, 1), cB + hstep + kstep, voffB);
        PG8_WAIT_V(6); PG8_BAR;
    } else {
        PG8_STAGE(PG8_SB(0, 0), cB, voffB); PG8_STAGE(PG8_SA(0, 0), cA, voffA); PG8_STAGE(PG8_SB(0, 1), cB + hstep, voffB); PG8_STAGE(PG8_SA(0, 1), cA + hstep, voffA);
        if (wr == 1) PG8_BAR;
        PG8_WAIT_V(4); PG8_BAR;
        PG8_STAGE(PG8_SB(1, 0), cB + kstep, voffB); PG8_STAGE(PG8_SA(1, 0), cA + kstep, voffA); PG8_STAGE(PG8_SB(1, 1), cB + hstep + kstep, voffB);
        PG8_WAIT_V(6); PG8_BAR;
    }
    for (;;) {
        const bool has_next = S.next(ui + 1, nxt);
        const char* nA = has_next ? (const char*)g.A + (size_t)nxt.pm * tstep : cA; const char* nB = has_next ? (const char*)g.Bt + (size_t)nxt.pn * tstep : cB;
        for (int t = 0; t < nt; t += 2) {
            const bool last = (t == nt - 2);
            const char* a1 = cA + (size_t)(t + 1) * kstep;
            const char* a2 = last ? nA : cA + (size_t)(t + 2) * kstep; const char* b2 = last ? nB : cB + (size_t)(t + 2) * kstep;
            const char* a3 = a2 + kstep; const char* b3 = b2 + kstep;
            if (last && has_next) S.a_ready(nxt);
            if constexpr (SP2) {
            PG8_LDB(B0, 0, 0); PG8_LDB(B1, 0, 1); PG8_SCHED; PG8_LDA(At, 0, 0); PG8_STAGE(PG8_SA(1, 1), a1 + hstep, voffA);
            PG8_WAIT_V(8); PG8_WAIT_L(0); PG8_BAR; PG8_MMA(0, 0, At, B0); PG8_MMA(0, 1, At, B1); PG8_BAR; PG8_SCHED;
            PG8_LDA(At, 0, 1); PG8_STAGE(PG8_SB(0, 0), b2, voffB); PG8_STAGE(PG8_SB(0, 1), b2 + hstep, voffB); PG8_STAGE(PG8_SA(0, 0), a2, voffA);
            PG8_WAIT_V(8); PG8_WAIT_L(0); PG8_BAR; PG8_MMA(1, 0, At, B0); PG8_MMA(1, 1, At, B1); PG8_BAR; PG8_SCHED;
            PG8_LDB(B0, 1, 0); PG8_LDB(B1, 1, 1); PG8_SCHED; PG8_LDA(At, 1, 0); PG8_STAGE(PG8_SA(0, 1), a2 + hstep, voffA);
            PG8_WAIT_V(8); PG8_WAIT_L(0); PG8_BAR; PG8_MMA(0, 0, At, B0); PG8_MMA(0, 1, At, B1); PG8_BAR; PG8_SCHED;
            PG8_LDA(At, 1, 1); PG8_STAGE(PG8_SB(1, 0), b3, voffB); PG8_STAGE(PG8_SB(1, 1), b3 + hstep, voffB); PG8_STAGE(PG8_SA(1, 0), a3, voffA);
            PG8_WAIT_V(8); PG8_WAIT_L(0); PG8_BAR; PG8_MMA(1, 0, At, B0); PG8_MMA(1, 1, At, B1); PG8_BAR; PG8_SCHED;
            } else {
            PG8_LDB(B0, 0, 0); PG8_SCHED; PG8_LDA(At, 0, 0); PG8_STAGE(PG8_SA(1, 1), a1 + hstep, voffA);
            PG8_WAIT_L(8); PG8_BAR; PG8_WAIT_L(0); PG8_MMA(0, 0, At, B0); PG8_BAR; PG8_SCHED;
            PG8_LDB(B1, 0, 1); PG8_STAGE(PG8_SB(0, 0), b2, voffB);
            PG8_BAR; PG8_WAIT_L(0); PG8_MMA(0, 1, At, B1); PG8_BAR;
            PG8_LDA(At, 0, 1); PG8_STAGE(PG8_SA(0, 0), a2, voffA);
            PG8_BAR; PG8_WAIT_L(0); PG8_MMA(1, 0, At, B0); PG8_BAR; PG8_SCHED;
            PG8_STAGE(PG8_SB(0, 1), b2 + hstep, voffB);
            PG8_WAIT_V(6); PG8_BAR; PG8_MMA(1, 1, At, B1); PG8_BAR;
            PG8_LDB(B0, 1, 0); PG8_SCHED; PG8_LDA(At, 1, 0); PG8_STAGE(PG8_SA(0, 1), a2 + hstep, voffA);
            PG8_WAIT_L(8); PG8_BAR; PG8_WAIT_L(0); PG8_MMA(0, 0, At, B0); PG8_BAR; PG8_SCHED;
            PG8_LDB(B1, 1, 1); PG8_STAGE(PG8_SB(1, 0), b3, voffB);
            PG8_BAR; PG8_WAIT_L(0); PG8_MMA(0, 1, At, B1); PG8_BAR;
            PG8_LDA(At, 1, 1); PG8_STAGE(PG8_SA(1, 0), a3, voffA);
            PG8_BAR; PG8_WAIT_L(0); PG8_MMA(1, 0, At, B0); PG8_BAR; PG8_SCHED;
            PG8_STAGE(PG8_SB(1, 1), b3 + hstep, voffB);
            PG8_WAIT_V(6); PG8_BAR; PG8_MMA(1, 1, At, B1); PG8_BAR;
            }
        }
        if constexpr (ALIGN_EPI) { if (wr == 0) PG8_BAR; }
        if constexpr (F8) asm volatile("s_nop 15\n\ts_nop 15" ::: "memory");
        if constexpr (!Epi::AFTER_DRAIN) { E(acc, cur, wr, wc, fr, fq); S.done(cur); }
        if (!has_next) break;
#pragma unroll
        for (int a = 0; a < 2; ++a)
#pragma unroll
            for (int b = 0; b < 2; ++b)
#pragma unroll
                for (int m = 0; m < 4; ++m)
#pragma unroll
                    for (int n = 0; n < 2; ++n) acc[a][b][m][n] = (f32x4){0.f, 0.f, 0.f, 0.f};
        cur = nxt; cA = nA; cB = nB; ++ui;
        if constexpr (ALIGN_EPI) { if (wr == 1) PG8_BAR; }
    }
    PG8_WAIT_V(0);
    if constexpr (!ALIGN_EPI) { if (wr == 0) PG8_BAR; }
    PG8_BAR;
    if constexpr (Epi::AFTER_DRAIN) { E.fused(acc, cur, wr, wc, fr, fq, lds, wid, lane); S.done(cur); }
#undef PG8_SA
#undef PG8_SB
#undef PG8_STAGE
#undef PG8_LDA
#undef PG8_LDB
#undef PG8_MMA
#undef PG8_WAIT_V
#undef PG8_WAIT_L
#undef PG8_BAR
#undef PG8_SCHED
}
}
namespace att {
using bf16 = unsigned short;
using bf16x8 = __attribute__((ext_vector_type(8))) short;
using s16x4  = __attribute__((ext_vector_type(4))) short;
using f32x16 = __attribute__((ext_vector_type(16))) float;
using u32x4  = __attribute__((ext_vector_type(4))) unsigned;
constexpr int NW = 8, QBLK = 32, KVBLK = 64;
constexpr int LDX = 4608;
constexpr int SHM_V = 16384, SHM_K = 16384, SHM_ATTN = 2 * SHM_V + 2 * SHM_K + NW * 64 * 4;
#define ATT_SBAR() __builtin_amdgcn_sched_barrier(0)
#define ATT_THR 8.f
__device__ __forceinline__ int crow(int r, int hi) { return (r & 3) + 8 * (r >> 2) + 4 * hi; }
__device__ __forceinline__ unsigned cvtpk(float lo, float hi) { unsigned r; asm volatile("v_cvt_pk_bf16_f32 %0, %1, %2" : "=v"(r) : "v"(lo), "v"(hi)); return r; }
template <int DQK> __device__ __forceinline__ int koff(int row, int colB) { return DQK == 128 ? row * 256 + (colB ^ ((row & 7) << 4)) : row * 128 + (colB ^ ((row & 7) << 4)); }

template <int DQK, bool NOMAX>
__device__ __forceinline__ void partialSM(f32x16& p0, f32x16& p1, float& m_reg, float& mn, float& alpha) {
  if constexpr (NOMAX) { mn = 0.f; alpha = 1.f;
#pragma unroll
    for (int r = 0; r < 16; ++r) p0[r] = __builtin_amdgcn_exp2f(p0[r]);
    return; }
  float pmax = p0[0];
#pragma unroll
  for (int r = 1; r < 16; ++r) pmax = fmaxf(pmax, p0[r]);
#pragma unroll
  for (int r = 0; r < 16; ++r) pmax = fmaxf(pmax, p1[r]);
  { auto rr = __builtin_amdgcn_permlane32_swap(__float_as_uint(pmax), __float_as_uint(pmax), false, false);
    pmax = fmaxf(__uint_as_float(rr[0]), __uint_as_float(rr[1])); }
  if (__builtin_expect(__all(pmax - m_reg <= ATT_THR), 1)) { mn = m_reg; alpha = 1.f; }
  else { mn = fmaxf(m_reg, pmax); alpha = __builtin_amdgcn_exp2f(m_reg - mn); m_reg = mn; }
#pragma unroll
  for (int r = 0; r < 16; ++r) p0[r] = p0[r] - mn;
#pragma unroll
  for (int r = 0; r < 16; ++r) p1[r] = p1[r] - mn;
#pragma unroll
  for (int r = 0; r < 16; ++r) p0[r] = __builtin_amdgcn_exp2f(p0[r]);
}
#define ATT_PK4(P, BASE, OUT) do { unsigned a0 = cvtpk(P[BASE + 0], P[BASE + 1]), a1 = cvtpk(P[BASE + 2], P[BASE + 3]);   \
    unsigned b0 = cvtpk(P[BASE + 4], P[BASE + 5]), b1 = cvtpk(P[BASE + 6], P[BASE + 7]);                              \
    auto r0 = __builtin_amdgcn_permlane32_swap(a0, b0, false, false); auto r1 = __builtin_amdgcn_permlane32_swap(a1, b1, false, false); \
    u32x4 w = {r0[0], r1[0], r0[1], r1[1]}; OUT = *reinterpret_cast<bf16x8*>(&w); } while (0)
__device__ __forceinline__ void finishSM(f32x16& p0, f32x16& p1, float alpha, float& l_reg, bf16x8& pa0, bf16x8& pa1, bf16x8& pa2, bf16x8& pa3) {
#pragma unroll
  for (int r = 0; r < 16; ++r) p1[r] = __builtin_amdgcn_exp2f(p1[r]);
  float ps = 0;
#pragma unroll
  for (int r = 0; r < 16; ++r) ps += p0[r];
#pragma unroll
  for (int r = 0; r < 16; ++r) ps += p1[r];
  { auto rr = __builtin_amdgcn_permlane32_swap(__float_as_uint(ps), __float_as_uint(ps), false, false);
    ps = __uint_as_float(rr[0]) + __uint_as_float(rr[1]); }
  l_reg = l_reg * alpha + ps;
  ATT_PK4(p0, 0, pa0); ATT_PK4(p0, 8, pa1); ATT_PK4(p1, 0, pa2); ATT_PK4(p1, 8, pa3);
}
template <int DQK>
__device__ __forceinline__ void qkt(f32x16& p0, f32x16& p1, const char* Ks, const bf16x8* qr, int r32, int hi) {
  p0 = f32x16{}; p1 = f32x16{};
#pragma unroll
  for (int d0 = 0; d0 < DQK / 16; ++d0) { int cb = (d0 * 16 + hi * 8) * 2;
    bf16x8 b0 = *reinterpret_cast<const bf16x8*>(Ks + koff<DQK>(r32, cb));
    bf16x8 b1 = *reinterpret_cast<const bf16x8*>(Ks + koff<DQK>(32 + r32, cb));
    p0 = __builtin_amdgcn_mfma_f32_32x32x16_bf16(b0, qr[d0], p0, 0, 0, 0);
    p1 = __builtin_amdgcn_mfma_f32_32x32x16_bf16(b1, qr[d0], p1, 0, 0, 0); }
}
__device__ __forceinline__ int v_st(int k, int c) { const int kk = (k & ~0xC) | ((k & 4) << 1) | ((k & 8) >> 1); return ((kk >> 3) * 4 + (c >> 5)) * 512 + ((kk & 7) * 32 + (c & 31)) * 2; }
__device__ __forceinline__ int v_rd_base(int lane) { return ((lane & 3) << 3) | (((lane >> 2) & 3) << 6) | (((lane >> 4) & 1) << 5) | (((lane >> 5) & 1) << 8); }
constexpr int v_rd_off(int d0, int ks, int half) { return d0 * 512 + ks * 4096 + half * 2048; }
template <int OFF> __device__ __forceinline__ s16x4 tr_read(int vb) {
  s16x4 r; asm volatile("ds_read_b64_tr_b16 %0, %1 offset:%2" : "=&v"(r) : "v"(vb), "i"(OFF) : "memory"); return r;
}
template <int D0> __device__ __forceinline__ void pv_one(f32x16& od, int vb, bf16x8 pa0, bf16x8 pa1, bf16x8 pa2, bf16x8 pa3) {
  const s16x4 l0 = tr_read<v_rd_off(D0, 0, 0)>(vb), h0 = tr_read<v_rd_off(D0, 0, 1)>(vb), l1 = tr_read<v_rd_off(D0, 1, 0)>(vb), h1 = tr_read<v_rd_off(D0, 1, 1)>(vb);
  const s16x4 l2 = tr_read<v_rd_off(D0, 2, 0)>(vb), h2 = tr_read<v_rd_off(D0, 2, 1)>(vb), l3 = tr_read<v_rd_off(D0, 3, 0)>(vb), h3 = tr_read<v_rd_off(D0, 3, 1)>(vb);
  asm volatile("s_waitcnt lgkmcnt(0)" ::: "memory"); ATT_SBAR();
#define ATT_PK(L, H) (bf16x8){L[0], L[1], L[2], L[3], H[0], H[1], H[2], H[3]}
  od = __builtin_amdgcn_mfma_f32_32x32x16_bf16(pa0, ATT_PK(l0, h0), od, 0, 0, 0);
  od = __builtin_amdgcn_mfma_f32_32x32x16_bf16(pa1, ATT_PK(l1, h1), od, 0, 0, 0);
  od = __builtin_amdgcn_mfma_f32_32x32x16_bf16(pa2, ATT_PK(l2, h2), od, 0, 0, 0);
  od = __builtin_amdgcn_mfma_f32_32x32x16_bf16(pa3, ATT_PK(l3, h3), od, 0, 0, 0);
#undef ATT_PK
}
__device__ __forceinline__ void pv_d0(f32x16* o, int vb, bf16x8 pa0, bf16x8 pa1, bf16x8 pa2, bf16x8 pa3) {
  pv_one<0>(o[0], vb, pa0, pa1, pa2, pa3); pv_one<1>(o[1], vb, pa0, pa1, pa2, pa3); pv_one<2>(o[2], vb, pa0, pa1, pa2, pa3); pv_one<3>(o[3], vb, pa0, pa1, pa2, pa3);
}

template <int DQK, bool NOMAX = false>
__device__ __forceinline__ void attn_body(const bf16* __restrict__ Qb, const bf16* __restrict__ Kh, const bf16* __restrict__ Vh, int seq, char* lds,
                                          f32x16 (&o)[4], float (&rli)[16], int tid_in) {
  int tid = tid_in; asm volatile("" : "+v"(tid));
  const int wid = tid >> 6, lane = tid & 63, r32 = lane & 31, hi = lane >> 5;
  char* V_lds = lds; char* K_lds = lds + 2 * SHM_V;
  float* ws = (float*)(lds + 2 * SHM_V + 2 * SHM_K) + wid * 64; float* li_l = ws; float* al_l = ws + 32;
  float m_reg = -1e30f, l_reg = 0; bf16x8 qr[DQK / 16];
#pragma unroll
  for (int d = 0; d < 4; ++d) o[d] = f32x16{};
  const bf16* Qw = Qb + (long)(wid * QBLK + r32) * LDX + hi * 8;
#pragma unroll
  for (int d0 = 0; d0 < DQK / 16; ++d0) qr[d0] = *reinterpret_cast<const bf16x8*>(Qw + d0 * 16);
  const int sr = tid >> 4, sc = (tid & 15) * 8, vst0 = v_st(sr, sc), vst1 = v_st(32 + sr, sc);
  const int kr = (DQK == 128) ? sr : (tid >> 3), kc = (DQK == 128) ? sc : (tid & 7) * 8;
  const int vb0 = (int)(uintptr_t)V_lds + v_rd_base(lane);
  const unsigned voff0 = (unsigned)(sr * LDX + sc) * 2u, voff1 = voff0 + 32u * LDX * 2u, koff0 = (unsigned)(kr * LDX + kc) * 2u, koff1 = koff0 + 32u * LDX * 2u;
  struct { bf16x8 vs0, vs1, ks0, ks1; } sr_[2];
#define SLOAD(i, k0) do { const char* vbp = (const char*)(Vh + (long)(k0) * LDX); const char* kbp = (const char*)(Kh + (long)(k0) * LDX); \
    sr_[i].vs0 = *reinterpret_cast<const bf16x8*>(vbp + voff0); sr_[i].vs1 = *reinterpret_cast<const bf16x8*>(vbp + voff1); \
    sr_[i].ks0 = *reinterpret_cast<const bf16x8*>(kbp + koff0); if (DQK == 128) sr_[i].ks1 = *reinterpret_cast<const bf16x8*>(kbp + koff1); } while (0)
#define SWRITE(b, i) do { *(bf16x8*)(V_lds + (b) * SHM_V + vst0) = sr_[i].vs0; *(bf16x8*)(V_lds + (b) * SHM_V + vst1) = sr_[i].vs1;  \
    *(bf16x8*)(K_lds + (b) * SHM_K + koff<DQK>(kr, kc * 2)) = sr_[i].ks0; if (DQK == 128) *(bf16x8*)(K_lds + (b) * SHM_K + koff<DQK>(32 + kr, kc * 2)) = sr_[i].ks1; } while (0)
#define SWAIT() do { if (DQK == 128) asm volatile("s_waitcnt vmcnt(4)" ::: "memory"); else asm volatile("s_waitcnt vmcnt(3)" ::: "memory"); } while (0)
#define RESC(a) do { if (!NOMAX && __any((a) < 1.f)) { if (hi == 0) al_l[r32] = (a); asm volatile("s_waitcnt lgkmcnt(0)" ::: "memory"); \
    _Pragma("unroll") for (int d = 0; d < 4; ++d) _Pragma("unroll") for (int r = 0; r < 16; ++r) o[d][r] *= al_l[crow(r, hi)]; } } while (0)
  f32x16 pA0, pA1, pB0, pB1; float mnA, mnB, alA, alB; bf16x8 pa0, pa1, pa2, pa3; const int NT = seq / KVBLK;
  constexpr int SE = 0, SO = 1;
  SLOAD(SE, 0); asm volatile("s_waitcnt vmcnt(0)" ::: "memory"); SWRITE(0, SE); __syncthreads();
  qkt<DQK>(pA0, pA1, K_lds, qr, r32, hi); partialSM<DQK, NOMAX>(pA0, pA1, m_reg, mnA, alA);
  SLOAD(SO, KVBLK); if (2 < NT) SLOAD(SE, 2 * KVBLK);
  if (2 < NT) SWAIT(); else asm volatile("s_waitcnt vmcnt(0)" ::: "memory");
  SWRITE(1, SO); __syncthreads();
  for (int j = 1; j + 1 < NT; j += 2) {
    ATT_SBAR(); qkt<DQK>(pB0, pB1, K_lds + SHM_K, qr, r32, hi);
    finishSM(pA0, pA1, alA, l_reg, pa0, pa1, pa2, pa3); ATT_SBAR();
    SLOAD(SO, (j + 2) * KVBLK); ATT_SBAR();
    pv_d0(o, vb0, pa0, pa1, pa2, pa3); partialSM<DQK, NOMAX>(pB0, pB1, m_reg, mnB, alB);
    __syncthreads(); SWAIT(); SWRITE(0, SE);
    RESC(alB); __syncthreads();
    ATT_SBAR(); qkt<DQK>(pA0, pA1, K_lds, qr, r32, hi);
    finishSM(pB0, pB1, alB, l_reg, pa0, pa1, pa2, pa3); ATT_SBAR();
    if (j + 3 < NT) SLOAD(SE, (j + 3) * KVBLK); ATT_SBAR();
    pv_d0(o, vb0 + SHM_V, pa0, pa1, pa2, pa3); partialSM<DQK, NOMAX>(pA0, pA1, m_reg, mnA, alA);
    __syncthreads(); if (j + 3 < NT) SWAIT(); else asm volatile("s_waitcnt vmcnt(0)" ::: "memory");
    SWRITE(1, SO);
    RESC(alA); __syncthreads();
  }
  ATT_SBAR(); qkt<DQK>(pB0, pB1, K_lds + SHM_K, qr, r32, hi);
  finishSM(pA0, pA1, alA, l_reg, pa0, pa1, pa2, pa3); ATT_SBAR();
  pv_d0(o, vb0, pa0, pa1, pa2, pa3); partialSM<DQK, NOMAX>(pB0, pB1, m_reg, mnB, alB);
  __syncthreads(); RESC(alB);
  finishSM(pB0, pB1, alB, l_reg, pa0, pa1, pa2, pa3); ATT_SBAR();
  pv_d0(o, vb0 + SHM_V, pa0, pa1, pa2, pa3);
  if (hi == 0) li_l[r32] = l_reg; asm volatile("s_waitcnt lgkmcnt(0)" ::: "memory");
#pragma unroll
  for (int r = 0; r < 16; ++r) rli[r] = __builtin_amdgcn_rcpf(li_l[crow(r, hi)]);
#undef SLOAD
#undef SWRITE
#undef SWAIT
#undef RESC
}
}
constexpr int DM = 2048, NB = 8, SEQL = 2048, CTXL = 256, TPB = SEQL + CTXL  , MROWS = NB * TPB  ;
constexpr int INC = 4608, QC = 2304;
constexpr int DQ_OFF = 0, GQ_OFF = 512, RQ_OFF = 1536, RG_OFF = 1792;
constexpr int DK_OFF = QC + 0, DV_OFF = QC + 512, GK_OFF = QC + 1024, GV_OFF = QC + 1280, RK_OFF = QC + 1536, RV_OFF = QC + 1792;
constexpr int NEXP = 16384;
constexpr float NEPS = 1e-6f;
constexpr float W8_SCALE = 64.f;
constexpr float GQA8_SCALE = 16.f;
constexpr int NWAVES = 8, NTHR = 512;
constexpr int NCHUNK = 18;

#ifndef DBG_MASK
#define DBG_MASK 0x3F
#endif
constexpr unsigned DBG = DBG_MASK;

constexpr size_t MiB = 1u << 20;
constexpr size_t WS_CTL = 0, CTL_ZERO_BYTES = 1 * MiB;
constexpr size_t WS_MOD = 1 * MiB;
constexpr size_t WS_SCAL = WS_MOD + (size_t)2 * 9 * 12288 * 4;
constexpr size_t WS_GAINS = WS_SCAL + 1024;
constexpr size_t WS_SUBK = 2 * MiB;
constexpr size_t WS_RST = 4 * MiB;
constexpr size_t WS_DSC = 40 * MiB;
constexpr size_t WS_PIDX = 76 * MiB, WS_PGATE = 85 * MiB;
constexpr size_t WS_ROPE = 94 * MiB;
constexpr size_t WS_WIN = 96 * MiB, WS_WOUT = 132 * MiB, WS_WPQ = 148 * MiB;
constexpr size_t WS_U8 = 164 * MiB, WS_V8 = 228 * MiB;
constexpr size_t WS_US = 3 * MiB, WS_VS = WS_US + 131072, WS_HS = WS_VS + 131072, WS_HSUM = WS_HS + 131072;
constexpr size_t WS_H8 = 292 * MiB;
constexpr size_t WS_ACT = 330 * MiB;
constexpr size_t WS_HN = 420 * MiB, WS_CAT = 492 * MiB, WS_QKV = 564 * MiB, WS_XS = 726 * MiB, WS_END = 870 * MiB;

constexpr int RING_BYTES = 131072, LDSCTL_OFF = RING_BYTES, MISC_OFF = LDSCTL_OFF + 320, LDS_BYTES = 147456;
constexpr int CW_BAR = 4096;

#define GAS __attribute__((address_space(1)))
#define LAS __attribute__((address_space(3)))
typedef unsigned short bf16;
typedef unsigned v4u __attribute__((ext_vector_type(4)));
typedef float f32x4 __attribute__((ext_vector_type(4)));
typedef float f32x2 __attribute__((ext_vector_type(2)));
typedef short bf16x8 __attribute__((ext_vector_type(8)));
typedef __bf16 bf16x2_t __attribute__((ext_vector_type(2)));
#define LDS_WAIT() asm volatile("s_waitcnt lgkmcnt(0)" ::: "memory")
#define VM_WAIT() asm volatile("s_waitcnt vmcnt(0)" ::: "memory")
__device__ __forceinline__ unsigned pk2(float lo, float hi) { f32x2 v = {lo, hi}; bf16x2_t b = __builtin_convertvector(v, bf16x2_t); return __builtin_bit_cast(unsigned, b); }
__device__ __forceinline__ float bflo(unsigned w) { return __uint_as_float(w << 16); }
__device__ __forceinline__ float bfhi(unsigned w) { return __uint_as_float(w & 0xffff0000u); }
__device__ __forceinline__ float bf2f(bf16 h) { return __uint_as_float((unsigned)h << 16); }
__device__ __forceinline__ bf16 f2bf(float f) { return (bf16)(pk2(f, 0.f) & 0xffffu); }
__device__ __forceinline__ float wave_sum(float v) {
#pragma unroll
    for (int o = 1; o < 64; o <<= 1) v += __shfl_xor(v, o);
    return v;
}
__device__ __forceinline__ float half_sum32(float v) {
#pragma unroll
    for (int o = 1; o < 32; o <<= 1) v += __shfl_xor(v, o);
    return v;
}
__device__ __forceinline__ unsigned f8x4(float a, float b, float c, float d) { int w = __builtin_amdgcn_cvt_pk_fp8_f32(a, b, 0, false); w = __builtin_amdgcn_cvt_pk_fp8_f32(c, d, w, true); return (unsigned)w; }
__device__ __forceinline__ unsigned f8x1(float a) { return (unsigned)__builtin_amdgcn_cvt_pk_fp8_f32(a, a, 0, false) & 0xffu; }
__device__ __forceinline__ float f8tof(unsigned b) { return __builtin_amdgcn_cvt_f32_fp8((int)b, 0); }
__device__ __forceinline__ int lane_id_now() { int l_; asm volatile("v_mbcnt_lo_u32_b32 %0, -1, 0\n\tv_mbcnt_hi_u32_b32 %0, -1, %0" : "=v"(l_)); return l_; }
typedef __amdgpu_buffer_rsrc_t rsrc_t;
__device__ __forceinline__ rsrc_t mk_rsrc(const void* p, unsigned bytes) { return __builtin_amdgcn_make_buffer_rsrc((void*)p, 0, bytes, 0x00020000); }
#define BST16(val, rs, vo, so) __builtin_amdgcn_raw_buffer_store_b16((short)(val), rs, vo, so, 0)
#define BST8(val, rs, vo, so) __builtin_amdgcn_raw_buffer_store_b8((char)(val), rs, vo, so, 0)
#define BST32F(val, rs, vo, so) __builtin_amdgcn_raw_buffer_store_b32(__float_as_int(val), rs, vo, so, 0)
#define BLD32F(rs, vo, so) __int_as_float(__builtin_amdgcn_raw_buffer_load_b32(rs, vo, so, 0))
#define BLD16(rs, vo, so) ((unsigned short)__builtin_amdgcn_raw_buffer_load_b16(rs, vo, so, 0))
#define BLD128(rs, vo, so) __builtin_bit_cast(v4u, __builtin_amdgcn_raw_buffer_load_b128(rs, vo, so, 0))
__device__ __forceinline__ float siluf(float x) { return x / (1.f + __expf(-x)); }

#define XB_TMO      128
#define XB_XCNT(j)  (256  + 64 * (j))
#define XB_XSUB(j)  (1280 + 64 * (j))
#define XB_XGEN(j)  (2304 + 64 * (j))
#define XB_TOP      3328
#define XB_TOPGEN   3392
#define XCD_BAR_WORDS 3456
#define XB_SPIN_CAP (1u << 18)
__device__ __forceinline__ unsigned xb_ld(unsigned* p)              { return __hip_atomic_load(p, __ATOMIC_RELAXED, __HIP_MEMORY_SCOPE_AGENT); }
__device__ __forceinline__ unsigned xb_add(unsigned* p, unsigned v) { return __hip_atomic_fetch_add(p, v, __ATOMIC_RELAXED, __HIP_MEMORY_SCOPE_AGENT); }
__device__ __forceinline__ unsigned xb_xcc_id() { return (unsigned)__builtin_amdgcn_s_getreg((3 << 11) | 20) & 0xFu; }
#define XB_SPIN(cond, bar) do { unsigned _sp = 0; while (cond) { __builtin_amdgcn_s_sleep(1); \
    if ((++_sp & 255u) == 0u) { if (xb_ld(&(bar)[XB_TMO])) break; if (_sp > XB_SPIN_CAP) { atomicAdd(&(bar)[XB_TMO], 1u); break; } } } } while (0)
struct XcdBarrier { unsigned* bar; unsigned x; volatile LAS unsigned* st; int wave; };
__device__ __forceinline__ XcdBarrier xcd_barrier_post(unsigned* bar, volatile LAS unsigned* st) {
    XcdBarrier b; b.bar = bar; b.x = xb_xcc_id(); b.st = st; b.wave = __builtin_amdgcn_readfirstlane((int)threadIdx.x >> 6);
    if (threadIdx.x == 0) st[2] = xb_add(&bar[XB_XCNT(b.x)], 1u);
    return b;
}
__device__ __forceinline__ void xcd_barrier_complete(unsigned* bar, unsigned x, unsigned& nloc, unsigned& nx) {
    const unsigned G = gridDim.x * gridDim.y * gridDim.z;
    unsigned sum, cnt, mine, sp = 0u;
    for (;;) {
        sum = 0u; cnt = 0u; mine = 0u;
#pragma unroll
        for (unsigned j = 0; j < 16; ++j) { const unsigned c = xb_ld(&bar[XB_XCNT(j)]); sum += c; cnt += (c > 0u) ? 1u : 0u; mine = (j == x) ? c : mine; }
        if (sum == G) break;
        __builtin_amdgcn_s_sleep(1);
        if ((++sp & 255u) == 0u) { if (xb_ld(&bar[XB_TMO])) break; if (sp > XB_SPIN_CAP) { atomicAdd(&bar[XB_TMO], 1u); break; } }
    }
    nloc = mine > 0u ? mine : 1u; nx = cnt > 0u ? cnt : 1u;
}
__device__ __forceinline__ void xcd_barrier(const XcdBarrier& b) {
    asm volatile("s_waitcnt vmcnt(0)" ::: "memory");
    __syncthreads();
    if (b.wave == 0 && lane_id_now() == 0) {
        unsigned* bar = b.bar;
        unsigned bx = b.x; asm volatile("" : "+s"(bx));
        __builtin_amdgcn_s_waitcnt(0);
        unsigned nloc = b.st[0], nx = b.st[1];
        if (nloc == 0u) { xcd_barrier_complete(bar, bx, nloc, nx); b.st[0] = nloc; b.st[1] = nx; }
        const unsigned old = xb_add(&bar[XB_XSUB(bx)], 1u);
        const unsigned gen = old / nloc;
        if (old + 1u == (gen + 1u) * nloc) {
            __builtin_amdgcn_fence(__ATOMIC_RELEASE, "agent");
            asm volatile("s_waitcnt vmcnt(0)" ::: "memory");
            const unsigned og = xb_add(&bar[XB_TOP], 1u);
            const unsigned tg = og / nx;
            if (og + 1u == (tg + 1u) * nx) xb_add(&bar[XB_TOPGEN], 1u);
            else XB_SPIN(xb_ld(&bar[XB_TOPGEN]) == tg, bar);
            xb_add(&bar[XB_XGEN(bx)], 1u);
            __builtin_amdgcn_fence(__ATOMIC_ACQUIRE, "agent");
            asm volatile("s_waitcnt vmcnt(0)" ::: "memory");
        } else {
            XB_SPIN(xb_ld(&bar[XB_XGEN(bx)]) == gen, bar);
            __builtin_amdgcn_fence(__ATOMIC_ACQUIRE, "agent");
            asm volatile("s_waitcnt vmcnt(0)" ::: "memory");
        }
    }
    __syncthreads();
}

namespace pg8 {
struct SegOrder {
    int nM[2], nN[2], rk[2], c0[2], start1, total, G, c;
    __device__ void init(int G_, int c_, int rk0, int c00, int nN0, int rk1, int c01, int nN1) {
        G = G_; c = c_; rk[0] = rk0; rk[1] = rk1; c0[0] = c00; c0[1] = c01; nN[0] = nN0; nN[1] = nN1;
        nM[0] = rk0 == 0 ? 72 : (rk0 == 1 ? 64 : 8); nM[1] = rk1 == 0 ? 72 : (rk1 == 1 ? 64 : 8);
        start1 = nM[0] * nN[0]; total = start1 + nM[1] * nN[1];
    }
    __device__ bool next(int i, Unit& u) const {
        const long L = (long)i * G + c; if (L >= total) return false;
        const int s = L >= start1 ? 1 : 0; int wgid = (int)L - (s ? start1 : 0);
        const int nwg = nM[s] * nN[s];
        { const int q = nwg / NXCD, r = nwg % NXCD, xcd = wgid % NXCD, off = wgid / NXCD; wgid = (xcd < r ? xcd * (q + 1) : r * (q + 1) + (xcd - r) * q) + off; }
        const int nig = WGM * nN[s], gid = wgid / nig, fm = gid * WGM, gsz = (nM[s] - fm) < WGM ? (nM[s] - fm) : WGM;
        const int j = fm + ((wgid % nig) % gsz);
        u.pm = rk[s] == 0 ? j : (rk[s] == 1 ? (j / 8) * 9 + 1 + (j % 8) : 9 * j);
        u.pn = c0[s] + (wgid % nig) / gsz; return true;
    }
    __device__ __forceinline__ void a_ready(const Unit&) const {}
    __device__ __forceinline__ void done(const Unit&) const {}
};
struct EpiResid {
    static constexpr bool PERM = true, AFTER_DRAIN = false;
    const float* xlat; const float* xctx; bf16_t* XS; const float* gate; float dbgs;
    __device__ __forceinline__ void operator()(const f32x4 (&acc)[2][2][4][2], const Unit& u, int wr, int wc, int fr, int fq) const {
        asm volatile("" : "+v"(fr));
        const int b = u.pm / 9, tt = u.pm % 9;
        const float* g = gate + (size_t)(tt == 0 ? 8 : b) * 12288;
        const float* src = xlat ? (tt == 0 ? xctx + (size_t)(b * 256) * 2048 : xlat + (size_t)(b * 2048 + (tt - 1) * 256) * 2048) : nullptr;
        bf16_t* dst = XS + (size_t)u.pm * 256 * 2048;
        const int col0 = u.pn * BM + wc * 32 + 8 * fq;
        f32x4 gv[2][2];
#pragma unroll
        for (int bj = 0; bj < 2; ++bj)
#pragma unroll
            for (int n = 0; n < 2; ++n) gv[bj][n] = *(const f32x4*)(g + col0 + bj * HALF + 4 * n) * dbgs;
#define ER_STORE(ro_, col_, x0_, x1_, ai_, bj_, m_) do { const f32x4 v0 = (x0_) + gv[bj_][0] * acc[ai_][bj_][m_][0], v1 = (x1_) + gv[bj_][1] * acc[ai_][bj_][m_][1]; \
            u32x4 o; o.x = cvt_pk_bf16(v0[0], v0[1]); o.y = cvt_pk_bf16(v0[2], v0[3]); o.z = cvt_pk_bf16(v1[0], v1[1]); o.w = cvt_pk_bf16(v1[2], v1[3]); *(u32x4*)(dst + (ro_) + (col_)) = o; } while (0)
        if (src) {
#pragma unroll
            for (int ai = 0; ai < 2; ++ai)
#pragma unroll
                for (int mh = 0; mh < 2; ++mh) { f32x4 xa[2][2][2];
#pragma unroll
                    for (int mq = 0; mq < 2; ++mq) { const size_t ro = (size_t)(ai * HALF + wr * 64 + (2 * mh + mq) * 16 + fr) * 2048;
#pragma unroll
                        for (int bj = 0; bj < 2; ++bj) { const int col = col0 + bj * HALF; xa[mq][bj][0] = *(const f32x4*)(src + ro + col); xa[mq][bj][1] = *(const f32x4*)(src + ro + col + 4); } }
                    __builtin_amdgcn_sched_barrier(0);
#pragma unroll
                    for (int mq = 0; mq < 2; ++mq) { const size_t ro = (size_t)(ai * HALF + wr * 64 + (2 * mh + mq) * 16 + fr) * 2048;
#pragma unroll
                        for (int bj = 0; bj < 2; ++bj) ER_STORE(ro, col0 + bj * HALF, xa[mq][bj][0], xa[mq][bj][1], ai, bj, 2 * mh + mq); }
                    __builtin_amdgcn_sched_barrier(0); }
        } else {
#pragma unroll
            for (int ai = 0; ai < 2; ++ai) { u32x4 xw[4][2];
#pragma unroll
                for (int m = 0; m < 4; ++m) { const size_t ro = (size_t)(ai * HALF + wr * 64 + m * 16 + fr) * 2048;
#pragma unroll
                    for (int bj = 0; bj < 2; ++bj) xw[m][bj] = *(const u32x4*)(dst + ro + col0 + bj * HALF); }
                __builtin_amdgcn_sched_barrier(0);
#pragma unroll
                for (int m = 0; m < 4; ++m) { const size_t ro = (size_t)(ai * HALF + wr * 64 + m * 16 + fr) * 2048;
#pragma unroll
                    for (int bj = 0; bj < 2; ++bj) { const u32x4 w = xw[m][bj];
                        const f32x4 x0 = {__uint_as_float(w.x << 16), __uint_as_float(w.x & 0xffff0000u), __uint_as_float(w.y << 16), __uint_as_float(w.y & 0xffff0000u)};
                        const f32x4 x1 = {__uint_as_float(w.z << 16), __uint_as_float(w.z & 0xffff0000u), __uint_as_float(w.w << 16), __uint_as_float(w.w & 0xffff0000u)};
                        ER_STORE(ro, col0 + bj * HALF, x0, x1, ai, bj, m); } }
                __builtin_amdgcn_sched_barrier(0); }
        }
#undef ER_STORE
    }
};
struct EpiQKV {
    static constexpr bool PERM = true, AFTER_DRAIN = false;
    bf16_t* O; const float* gains; const float* rope; PG8_LAS float* P;
    __device__ __forceinline__ void operator()(const f32x4 (&acc)[2][2][4][2], const Unit& u, int wr, int wc, int fr, int fq) const {
        if (!gains) return;
        const int pn = u.pn;
        const int mode = (pn < 2 || pn == 9 || pn == 10) ? 1 : (((pn >= 2 && pn <= 5) || pn == 13) ? 2 : (pn == 15 ? 3 : 0));
        const int tt = u.pm % 9; const bool isctx = tt == 0;
        int fro = fr; asm volatile("" : "+v"(fro));
        PG8_LAS float* pb = P + (wr * 64 + fro) * 8;
        const float* gain = gains + (mode == 1 ? (pn < 2 ? 0 : 128) : (pn <= 5 ? 256 : 384));
        if (mode == 1 || mode == 2) {
#pragma unroll
            for (int ai = 0; ai < 2; ++ai)
#pragma unroll
                for (int m = 0; m < 4; ++m)
#pragma unroll
                    for (int bj = 0; bj < 2; ++bj) { const f32x4 a = acc[ai][bj][m][0], b = acc[ai][bj][m][1];
                        float s = (a[0] * a[0] + a[1] * a[1]) + (a[2] * a[2] + a[3] * a[3]) + (b[0] * b[0] + b[1] * b[1]) + (b[2] * b[2] + b[3] * b[3]);
                        s += __shfl_xor(s, 16); s += __shfl_xor(s, 32);
                        if (fq == 0) pb[(ai * HALF + m * 16) * 8 + bj * 4 + wc] = s; }
            asm volatile("s_waitcnt lgkmcnt(0)" ::: "memory"); __builtin_amdgcn_s_barrier(); asm volatile("" ::: "memory");
        }
        const int cw = wc * 32 + 8 * fq;
        f32x4 g0[2], g1[2];
#pragma unroll
        for (int bj = 0; bj < 2; ++bj) { const int cv = mode == 1 ? ((bj * HALF + cw) & 63) : ((bj * HALF + cw) & 127);
            if (mode == 1 || mode == 2) { g0[bj] = *(const f32x4*)(gain + cv); g1[bj] = *(const f32x4*)(gain + cv + 4); } else { g0[bj] = (f32x4){1.f, 1.f, 1.f, 1.f}; g1[bj] = g0[bj]; } }
        const float sc3 = mode == 3 ? 0.125f : (pn < 2 ? 0.125f * 1.4426950408889634f : (pn <= 5 ? 0.088388347648318440f * 1.4426950408889634f : 1.f));
        float fr4[2][4]; bool rc[2];
#pragma unroll
        for (int bj = 0; bj < 2; ++bj) { const int cv = mode == 1 ? ((bj * HALF + cw) & 63) : ((bj * HALF + cw) & 127); const int i0 = cv >> 1;
            rc[bj] = mode == 1 ? (i0 >= 16) : (i0 >= 32);
#pragma unroll
            for (int q = 0; q < 4; ++q) { const int i = i0 + q; fr4[bj][q] = mode == 1 ? exp2f(-(float)(2 * (i & 15)) * (13.287712379549449f / 32.f)) : exp2f(-(float)(2 * (i & 31)) * (13.287712379549449f / 64.f)); } }
#pragma unroll
        for (int ai = 0; ai < 2; ++ai)
#pragma unroll
            for (int m = 0; m < 4; ++m) { const int rr = ai * HALF + wr * 64 + m * 16 + fr;
                bf16_t* rowp = O + (size_t)(u.pm * BM + rr) * 4608 + pn * BM + cw;
                const int tok = (tt - 1) * 256 + rr;
                const float prow = (float)(tok >> 6) * 0.15915494309189535f, pcol = (float)(tok & 63) * 0.15915494309189535f;
#pragma unroll
                for (int bj = 0; bj < 2; ++bj) { f32x4 v0 = acc[ai][bj][m][0], v1 = acc[ai][bj][m][1];
                    if (mode == 1 || mode == 2) { const PG8_LAS float* pp = pb + (ai * HALF + m * 16) * 8 + bj * 4;
                        const float tot = mode == 1 ? pp[wc & 2] + pp[(wc & 2) + 1] : (pp[0] + pp[1]) + (pp[2] + pp[3]);
                        const float r = rsqrtf(tot * (mode == 1 ? 1.f / 64.f : 1.f / 128.f) + 1e-6f); v0 = v0 * r * g0[bj]; v1 = v1 * r * g1[bj];
                        if (!isctx) { const float pos = rc[bj] ? pcol : prow;
                            float c4[4], s4[4];
#pragma unroll
                            for (int q = 0; q < 4; ++q) { const float a = pos * fr4[bj][q]; s4[q] = __builtin_amdgcn_sinf(a); c4[q] = __builtin_amdgcn_cosf(a); }
                            const f32x4 w0 = {v0[0] * c4[0] - v0[1] * s4[0], v0[0] * s4[0] + v0[1] * c4[0], v0[2] * c4[1] - v0[3] * s4[1], v0[2] * s4[1] + v0[3] * c4[1]};
                            const f32x4 w1 = {v1[0] * c4[2] - v1[1] * s4[2], v1[0] * s4[2] + v1[1] * c4[2], v1[2] * c4[3] - v1[3] * s4[3], v1[2] * s4[3] + v1[3] * c4[3]};
                            v0 = w0; v1 = w1; } }
                    v0 = v0 * sc3; v1 = v1 * sc3;
                    u32x4 w; w.x = cvt_pk_bf16(v0[0], v0[1]); w.y = cvt_pk_bf16(v0[2], v0[3]); w.z = cvt_pk_bf16(v1[0], v1[1]); w.w = cvt_pk_bf16(v1[2], v1[3]);
                    *(u32x4*)(rowp + bj * HALF) = w; }
                asm volatile("" ::: "memory"); }
    }
};
__device__ __forceinline__ size_t qp_frag_index(int token, int col) {
    const int tg = token >> 5, n = token & 31, head = col >> 8, p = (col >> 7) & 1, ks = (col >> 4) & 7, hi = (col >> 3) & 1, j = col & 7;
    return ((((((size_t)tg * 8 + head) * 2 + p) * 8 + ks) * 2 + hi) * 32 + n) * 8 + j;
}
struct EpiQP {
    static constexpr bool PERM = true, AFTER_DRAIN = false;
    bf16_t* O;
    __device__ __forceinline__ void operator()(const f32x4 (&acc)[2][2][4][2], const Unit& u, int wr, int wc, int fr, int fq) const {
        const rsrc_t rs = mk_rsrc(O + ((size_t)(u.pm * 8 + wr * 2) * 65536 + (size_t)u.pn * 8192), 6u * 65536u * 2u + 65536u * 2u);
        const unsigned vo = (unsigned)((2 * wc + (fq >> 1)) * 512 + (fq & 1) * 256 + fr * 8) * 2u;
#pragma unroll
        for (int ai = 0; ai < 2; ++ai)
#pragma unroll
            for (int m = 0; m < 4; ++m)
#pragma unroll
                for (int bj = 0; bj < 2; ++bj) { const f32x4 v0 = acc[ai][bj][m][0], v1 = acc[ai][bj][m][1];
                    u32x4 w; w.x = cvt_pk_bf16(v0[0], v0[1]); w.y = cvt_pk_bf16(v0[2], v0[3]); w.z = cvt_pk_bf16(v1[0], v1[1]); w.w = cvt_pk_bf16(v1[2], v1[3]);
                    __builtin_amdgcn_raw_buffer_store_b128(w, rs, vo, ((ai * 4 + (m >> 1)) * 65536 + bj * 4096 + (m & 1) * 128) * 2, 0); }
    }
};
}
struct Args { const float* in[22]; float* out; unsigned char* ws; int ph_lo, ph_hi, li, pad; };
struct Frame { LAS unsigned char* lds; unsigned char* ldsg; int tid, lane, wave, vcu, G; int px, pnx, prank, pcnt; };
__device__ __forceinline__ Frame refresh(const Frame& F0) { Frame F = F0;
    int t = F0.wave * 64 + lane_id_now();
    asm volatile("" : "+v"(t)); F.tid = t; F.lane = t & 63; return F; }
#define IN_X 0
#define IN_C 1
#define IN_CTX 2
#define IN_CCTX 3
#define IN_N1G 4
#define IN_N2G 5
#define IN_WMOD 6
#define IN_BMOD 7
#define IN_WIN 8
#define IN_WOUT 9
#define IN_DQG 10
#define IN_DKG 11
#define IN_DLAM 12
#define IN_DOG 13
#define IN_GQG 14
#define IN_GKG 15
#define IN_RDEC 16
#define IN_ROG 17
#define IN_PWQ 18
#define IN_PSK 19
#define IN_PU 20
#define IN_PV 21

__device__ __forceinline__ void p0_transpose_item_bf16(const float* W, int K, int N, bf16* WT, LAS float* scr, int item, int lane) {
    const int nblk = N / 32, kb = item / nblk, nb = item % nblk, k0 = 64 * kb, n0 = 32 * nb;
#pragma unroll
    for (int i = 0; i < 32; ++i) { const int kk = 2 * i + (lane >> 5); scr[kk * 33 + (lane & 31)] = W[(size_t)(k0 + kk) * N + n0 + (lane & 31)]; }
    LDS_WAIT(); asm volatile("" ::: "memory");
    const int c = lane & 7;
#pragma unroll
    for (int j = 0; j < 4; ++j) { const int n = (lane >> 3) + 8 * j; const LAS float* s = scr + (8 * c) * 33 + n;
        v4u o; o.x = pk2(s[0 * 33], s[1 * 33]); o.y = pk2(s[2 * 33], s[3 * 33]); o.z = pk2(s[4 * 33], s[5 * 33]); o.w = pk2(s[6 * 33], s[7 * 33]);
        *(GAS v4u*)(WT + (size_t)(n0 + n) * K + k0 + 8 * c) = o; }
    LDS_WAIT(); asm volatile("" ::: "memory");
}
__device__ __forceinline__ void p0_transpose_item(const float* W, int K, int N, unsigned char* WT, LAS float* scr, int item, int lane, int klo, int khi, float kscale) {
    const int nblk = N / 32, kb = item / nblk, nb = item % nblk, k0 = 64 * kb, n0 = 32 * nb;
#pragma unroll
    for (int i = 0; i < 32; ++i) { const int kk = 2 * i + (lane >> 5); scr[kk * 33 + (lane & 31)] = W[(size_t)(k0 + kk) * N + n0 + (lane & 31)]; }
    LDS_WAIT(); asm volatile("" ::: "memory");
    const int c = lane & 3;
    const float sc = W8_SCALE * ((k0 >= klo && k0 < khi) ? kscale : 1.f);
#pragma unroll
    for (int j = 0; j < 2; ++j) { const int n = (lane >> 2) + 16 * j; const LAS float* s = scr + (16 * c) * 33 + n;
        v4u o; o.x = f8x4(s[0 * 33] * sc, s[1 * 33] * sc, s[2 * 33] * sc, s[3 * 33] * sc); o.y = f8x4(s[4 * 33] * sc, s[5 * 33] * sc, s[6 * 33] * sc, s[7 * 33] * sc);
        o.z = f8x4(s[8 * 33] * sc, s[9 * 33] * sc, s[10 * 33] * sc, s[11 * 33] * sc); o.w = f8x4(s[12 * 33] * sc, s[13 * 33] * sc, s[14 * 33] * sc, s[15 * 33] * sc);
        *(GAS v4u*)(WT + (size_t)(n0 + n) * K + k0 + 16 * c) = o; }
    LDS_WAIT(); asm volatile("" ::: "memory");
}
__device__ __forceinline__ void cvt8(const float* src, bf16* dst, size_t i8) {
    const f32x4 a = *(const f32x4*)(src + i8 * 8), b = *(const f32x4*)(src + i8 * 8 + 4);
    v4u o; o.x = pk2(a.x, a.y); o.y = pk2(a.z, a.w); o.z = pk2(b.x, b.y); o.w = pk2(b.z, b.w);
    *(v4u*)(dst + i8 * 8) = o;
}
__device__ __forceinline__ void quant_u_row(const Args& A, int lane, int rowid) {
    unsigned char* ws = A.ws;
    const float* src = A.in[IN_PU] + (size_t)rowid * 2048 + lane * 32;
    f32x4 v[8]; float ss = 0.f;
#pragma unroll
    for (int j = 0; j < 8; ++j) { v[j] = *(const f32x4*)(src + j * 4); ss += (v[j].x * v[j].x + v[j].y * v[j].y) + (v[j].z * v[j].z + v[j].w * v[j].w); }
    ss = wave_sum(ss);
    const float sc = ss > 0.f ? 0.5f * sqrtf(ss * (1.f / 2048.f)) : 1.f, inv = 1.f / sc;
    if (lane == 0) ((float*)(ws + WS_US))[(size_t)rowid * 2] = sc;
    v4u o;
#pragma unroll
    for (int q = 0; q < 4; ++q) { const f32x4 a = v[2 * q], b = v[2 * q + 1];
        unsigned w = __builtin_amdgcn_cvt_scalef32_pk_fp4_f32(0u, a.x * inv, a.y * inv, 1.f, 0); w = __builtin_amdgcn_cvt_scalef32_pk_fp4_f32(w, a.z * inv, a.w * inv, 1.f, 1);
        w = __builtin_amdgcn_cvt_scalef32_pk_fp4_f32(w, b.x * inv, b.y * inv, 1.f, 2); w = __builtin_amdgcn_cvt_scalef32_pk_fp4_f32(w, b.z * inv, b.w * inv, 1.f, 3);
        if (q == 0) o.x = w; else if (q == 1) o.y = w; else if (q == 2) o.z = w; else o.w = w; }
    *(v4u*)(ws + WS_U8 + (size_t)rowid * 1024 + lane * 16) = o;
}
__device__ __forceinline__ void quant_v_row(const Args& A, int lane, int rowid) {
    unsigned char* ws = A.ws;
    const float* src = A.in[IN_PV] + (size_t)rowid * 2048 + lane * 4;
    f32x4 v[8]; float ss = 0.f;
#pragma unroll
    for (int j = 0; j < 8; ++j) { v[j] = *(const f32x4*)(src + j * 256); ss += (v[j].x * v[j].x + v[j].y * v[j].y) + (v[j].z * v[j].z + v[j].w * v[j].w); }
    ss = wave_sum(ss);
    const float sc = ss > 0.f ? 0.5f * sqrtf(ss * (1.f / 2048.f)) : 1.f, inv = 1.f / sc;
    if (lane == 0) ((float*)(ws + WS_US))[(size_t)rowid * 2 + 1] = sc;
    unsigned short* dst = (unsigned short*)(ws + WS_V8 + (size_t)rowid * 1024) + lane;
#pragma unroll
    for (int j = 0; j < 8; ++j) { unsigned w = __builtin_amdgcn_cvt_scalef32_pk_fp4_f32(0u, v[j].x * inv, v[j].y * inv, 1.f, 0); w = __builtin_amdgcn_cvt_scalef32_pk_fp4_f32(w, v[j].z * inv, v[j].w * inv, 1.f, 1);
        dst[j * 64] = (unsigned short)w; }
}
__device__ __forceinline__ void quant_fill(const Args& A, const Frame& F0, int j0, int j1, int idle_rank, int n_idle) {
    const Frame F = refresh(F0);
    for (int j = j0 + idle_rank * NWAVES + F.wave; j < j1; j += n_idle * NWAVES) { const int lay = j >> 15, jj = j & 32767;
        if (jj < NEXP) quant_u_row(A, F.lane, lay * NEXP + jj); else quant_v_row(A, F.lane, lay * NEXP + jj - NEXP); }
}
__device__ __forceinline__ void phase_prologue(const Args& A, const Frame& F0, int pmode = 0) {
    const Frame F = refresh(F0);
    unsigned char* ws = A.ws;
    for (int it = F.vcu; it < (pmode == 2 ? 0 : 192); it += F.G) {
        const int layer = it / 96, cg = it % 96;
        LAS float* S = (LAS float*)F.lds;
        for (int idx = F.tid; idx < 9 * 2048; idx += NTHR) { const int r = idx >> 11, k = idx & 2047; const float v = r < 8 ? A.in[IN_C][r * 2048 + k] : A.in[IN_CCTX][k]; S[idx] = siluf(v); }
        __syncthreads();
        const int cq = F.tid & 31, ks = F.tid >> 5;
        f32x4 acc[9];
#pragma unroll
        for (int r = 0; r < 9; ++r) acc[r] = (f32x4){0.f, 0.f, 0.f, 0.f};
        const float* Wp = A.in[IN_WMOD] + ((size_t)layer * 2048 + ks * 128) * 12288 + cg * 128 + cq * 4;
#pragma unroll 16
        for (int kk = 0; kk < 128; ++kk) { const f32x4 w = *(const f32x4*)(Wp + (size_t)kk * 12288); const int k = ks * 128 + kk;
#pragma unroll
            for (int r = 0; r < 9; ++r) acc[r] += S[r * 2048 + k] * w; }
        __syncthreads();
        LAS float* P = (LAS float*)F.lds;
#pragma unroll
        for (int r = 0; r < 9; ++r) *(LAS f32x4*)(P + (ks * 9 + r) * 128 + cq * 4) = acc[r];
        __syncthreads();
        for (int o = F.tid; o < 9 * 128; o += NTHR) { const int r = o >> 7, cc = o & 127; float s = A.in[IN_BMOD][layer * 12288 + cg * 128 + cc];
#pragma unroll
            for (int q = 0; q < 16; ++q) s += P[(q * 9 + r) * 128 + cc];
            ((float*)(ws + WS_MOD))[(size_t)(layer * 9 + r) * 12288 + cg * 128 + cc] = s; }
        __syncthreads();
    }
    if (F.vcu == F.G - 1 && F.wave == 0) {
#pragma unroll
        for (int l = 0; l < 2; ++l) { const int i = F.lane; const float* lp = A.in[IN_DLAM] + l * 256;
            const float s0 = wave_sum(lp[i] * lp[64 + i]), s1 = wave_sum(lp[128 + i] * lp[192 + i]);
            const float lam_init = 0.8f - 0.6f * expf(-0.3f * (float)l); float* sc = (float*)(ws + WS_SCAL) + l * 16;
            if (i < 8) { const float z = A.in[IN_RDEC][l * 8 + i]; sc[2 + i] = -log2f(1.f + expf(-z)); }
            float mdq = fabsf(A.in[IN_DQG][l * 64 + i]), mdk = fabsf(A.in[IN_DKG][l * 64 + i]);
            float mgq = fmaxf(fabsf(A.in[IN_GQG][l * 128 + i]), fabsf(A.in[IN_GQG][l * 128 + 64 + i])), mgk = fmaxf(fabsf(A.in[IN_GKG][l * 128 + i]), fabsf(A.in[IN_GKG][l * 128 + 64 + i]));
#pragma unroll
            for (int o = 1; o < 64; o <<= 1) { mdq = fmaxf(mdq, __shfl_xor(mdq, o)); mdk = fmaxf(mdk, __shfl_xor(mdk, o)); mgq = fmaxf(mgq, __shfl_xor(mgq, o)); mgk = fmaxf(mgk, __shfl_xor(mgk, o)); }
            const float bg = 1.05f * 128.f * mgq * mgk * 0.088388347648318440f * 1.4426950408889634f, bd = 1.05f * 64.f * mdq * mdk * 0.125f * 1.4426950408889634f;
            if (i == 0) { sc[0] = expf(s0) - expf(s1) + lam_init; sc[1] = lam_init; sc[10] = (bg < 40.f) ? 1.f : 0.f; sc[11] = (bd < 40.f) ? 1.f : 0.f; } } }
    if (F.vcu == F.G - 2 || (F.G < 2 && F.vcu == 0)) { for (int i = F.tid; i < 2 * 4 * 128; i += NTHR) { const int l = i >> 9, st = (i >> 7) & 3, c = i & 127; float v = 1.f;
        if (st == 0) { if (c < 64) v = A.in[IN_DQG][l * 64 + c]; } else if (st == 1) { if (c < 64) v = A.in[IN_DKG][l * 64 + c]; } else if (st == 2) v = A.in[IN_GQG][l * 128 + c]; else v = A.in[IN_GKG][l * 128 + c];
        ((float*)(ws + WS_GAINS))[i] = v; } }
    { LAS float* scr = (LAS float*)(F.lds + F.wave * 16384);
      const int gw = F.vcu * NWAVES + F.wave, NGW = F.G * NWAVES;
      constexpr int I_IN = 32 * 144, I_O = 32 * 64, PER = I_IN + 2 * I_O;
      const int NIT = pmode == 1 ? 0 : 2 * PER, nfree = F.G > 192 ? F.G - 192 : 0, NA = (nfree > 0 && pmode == 0) ? (int)(0.28f * (float)NIT) : 0;
      int it = F.vcu >= 192 ? (F.vcu - 192) * NWAVES + F.wave : NA, step = nfree * NWAVES; bool poolA = F.vcu >= 192 && NA > 0;
      if (!poolA) { it = NA + gw; step = NGW; }
      for (;;) {
          if (poolA && it >= NA) { poolA = false; it = NA + gw; step = NGW; }
          if (it >= NIT) break;
          const int l = it / PER; int r = it % PER; it += step;
          if (r < I_IN) { p0_transpose_item(A.in[IN_WIN] + (size_t)l * 2048 * 4608, 2048, 4608, ws + WS_WIN + (size_t)l * 4608 * 2048, scr, r, F.lane, 0, 0, 1.f); continue; } r -= I_IN;
          if (r < I_O) { p0_transpose_item(A.in[IN_WOUT] + (size_t)l * 2048 * 2048, 2048, 2048, ws + WS_WOUT + (size_t)l * 2048 * 2048, scr, r, F.lane, 512, 1536, 1.f / GQA8_SCALE); continue; } r -= I_O;
          p0_transpose_item_bf16(A.in[IN_PWQ] + (size_t)l * 2048 * 2048, 2048, 2048, (bf16*)(ws + WS_WPQ) + (size_t)l * 2048 * 2048, scr, r, F.lane); } }
    { const size_t gt = (size_t)F.vcu * NTHR + F.tid, GT = (size_t)F.G * NTHR;
      constexpr size_t NS8 = (size_t)2 * 8 * 2 * 128 * 128 / 8;
      for (size_t i = gt; i < NS8; i += GT) { const int n = (int)(i & 31), hi = (int)(i >> 5) & 1, ks = (int)(i >> 6) & 7, kb = (int)(i >> 9) & 3; const size_t lhp = i >> 11;
          const float* src = A.in[IN_PSK] + (lhp * 128 + kb * 32 + n) * 128 + ks * 16 + hi * 8;
          const f32x4 a = *(const f32x4*)src, b = *(const f32x4*)(src + 4);
          v4u o; o.x = pk2(a.x, a.y); o.y = pk2(a.z, a.w); o.z = pk2(b.x, b.y); o.w = pk2(b.z, b.w);
          *(v4u*)((bf16*)(ws + WS_SUBK) + i * 8) = o; }
 }
}

__device__ __forceinline__ void phase_rownorm(const Args& A, const Frame& F0, int l, int kind, bool with_ctx) {
    const Frame F = refresh(F0);
    const int gw = F.vcu * NWAVES + F.wave, NGW = F.G * NWAVES;
    const float* gain = A.in[kind == 1 ? IN_N2G : IN_N1G] + l * 2048;
    const float* mod = (const float*)(A.ws + WS_MOD) + (size_t)l * 9 * 12288;
    const bf16* XSb = (const bf16*)(A.ws + WS_XS); unsigned char* HN = A.ws + WS_HN;
    const bool blocked = NGW * 9 == MROWS;
    const int nrow = blocked ? 9 : (MROWS - gw + NGW - 1) / NGW;
#define RN_ROW(k_) (blocked ? gw * 9 + (k_) : gw + (k_) * NGW)
#define RN_LOAD(V_, R_) do { const int Rl_ = (R_) < MROWS ? (R_) : 0; const int bl_ = Rl_ / TPB, tl_ = Rl_ % TPB; \
        const float* src_ = tl_ < CTXL ? A.in[IN_CTX] + (size_t)(bl_ * 256 + tl_) * 2048 : A.in[IN_X] + (size_t)(bl_ * 2048 + tl_ - 256) * 2048; \
        _Pragma("unroll") for (int j = 0; j < 8; ++j) { \
            if (kind) { const f32x2 w2 = *(const f32x2*)(XSb + (size_t)Rl_ * 2048 + j * 256 + F.lane * 4); const unsigned a_ = ((const unsigned*)&w2)[0], c_ = ((const unsigned*)&w2)[1]; V_[j] = (f32x4){bflo(a_), bfhi(a_), bflo(c_), bfhi(c_)}; } \
            else V_[j] = *(const f32x4*)(src_ + j * 256 + F.lane * 4); } } while (0)
    f32x4 av[8], sv[8]; int cur_m = -1;
    f32x4 vn[8];
    if (nrow > 0) RN_LOAD(vn, RN_ROW(0));
    for (int k = 0; k < nrow; ++k) {
        const int R = RN_ROW(k);
        f32x4 v[8];
#pragma unroll
        for (int j = 0; j < 8; ++j) v[j] = vn[j];
        if (k + 1 < nrow) RN_LOAD(vn, RN_ROW(k + 1));
        const int b = R / TPB, tp = R % TPB; const bool isc = tp < CTXL;
        if (isc && !with_ctx) continue;
        const int mrow = isc ? 8 : b;
        if (mrow != cur_m) { cur_m = mrow; const float* mr = mod + (size_t)mrow * 12288 + (kind == 1 ? 3 * 2048 : 0);
            f32x4 gt_[8], st_[8];
#pragma unroll
            for (int j = 0; j < 8; ++j) { const int col = j * 256 + F.lane * 4; gt_[j] = *(const f32x4*)(gain + col); st_[j] = *(const f32x4*)(mr + 2048 + col); sv[j] = *(const f32x4*)(mr + col); }
            __builtin_amdgcn_sched_barrier(0);
#pragma unroll
            for (int j = 0; j < 8; ++j) av[j] = gt_[j] * (st_[j] + 1.f); }
        float ss = 0.f;
#pragma unroll
        for (int j = 0; j < 8; ++j) ss += (v[j].x * v[j].x + v[j].y * v[j].y) + (v[j].z * v[j].z + v[j].w * v[j].w);
        const float rstd = rsqrtf(wave_sum(ss) * (1.f / 2048.f) + NEPS);
        float mx = 0.f;
#pragma unroll
        for (int j = 0; j < 8; ++j) { const int col = j * 256 + F.lane * 4;
            const f32x4 y = (v[j] * rstd) * av[j] + sv[j]; v[j] = y;
            mx = fmaxf(mx, fmaxf(fmaxf(fabsf(y.x), fabsf(y.y)), fmaxf(fabsf(y.z), fabsf(y.w))));
            if (kind == 1) { f32x2 o; ((unsigned*)&o)[0] = pk2(y.x, y.y); ((unsigned*)&o)[1] = pk2(y.z, y.w); *(f32x2*)((bf16*)HN + (size_t)R * 2048 + col) = o; }
            else *(unsigned*)(HN + (size_t)R * 2048 + col) = f8x4(y.x, y.y, y.z, y.w); }
        if (kind == 1) {
#pragma unroll
            for (int o = 1; o < 64; o <<= 1) mx = fmaxf(mx, __shfl_xor(mx, o));
            const float sc = mx > 0.f ? mx * (1.f / 240.f) : 1.f, inv = 1.f / sc;
            unsigned* dst = (unsigned*)(A.ws + WS_H8 + (size_t)R * 2048) + F.lane;
#pragma unroll
            for (int j = 0; j < 8; ++j) dst[j * 64] = f8x4(v[j].x * inv, v[j].y * inv, v[j].z * inv, v[j].w * inv);
            if (F.lane == 0) ((float*)(A.ws + WS_HS))[R] = sc;
        }
    }
#undef RN_ROW
#undef RN_LOAD
}

__device__ __forceinline__ void rope_apply(float& y1, float& y2, float ang) { float s, c; sincosf(ang, &s, &c); const float a = y1 * c - y2 * s, b2 = y1 * s + y2 * c; y1 = a; y2 = b2; }
__device__ __forceinline__ void phase_rope(const Args& A, const Frame& F0, int l) {
    const Frame F = refresh(F0);
    const int gw = F.vcu * NWAVES + F.wave, NGW = F.G * NWAVES, lane = F.lane;
    bf16* QKV = (bf16*)(A.ws + WS_QKV);
    const float* dqg = A.in[IN_DQG] + l * 64; const float* dkg = A.in[IN_DKG] + l * 64; const float* gqg = A.in[IN_GQG] + l * 128; const float* gkg = A.in[IN_GKG] + l * 128;
    const int hw = lane >> 5, li = lane & 31;
    const float if64 = exp2f(-(float)(2 * (li & 15)) * (13.287712379549449f / 32.f));
    const float if128 = exp2f(-(float)(2 * (lane & 31)) * (13.287712379549449f / 64.f));
    for (int R = gw; R < MROWS; R += NGW) {
        const int tp = R % TPB; const bool isc = tp < CTXL; const int t = tp - CTXL;
        const float prow = (float)(t >> 6), pcol = (float)(t & 63);
        bf16* q = QKV + (size_t)R * INC;
        const float ang64 = (li < 16 ? prow : pcol) * if64, ang128 = (lane < 32 ? prow : pcol) * if128;
#pragma unroll
        for (int s = 0; s < 8; ++s) {
            const bool isq = s < 4; if (isq && isc && l == 1) continue;
            const int v = 2 * (s & 3) + hw; unsigned* p = (unsigned*)(q + (isq ? DQ_OFF : DK_OFF) + v * 64) + li; const float* g = isq ? dqg : dkg;
            const unsigned w = *p; float x1 = bflo(w), x2 = bfhi(w);
            const float rstd = rsqrtf(half_sum32(x1 * x1 + x2 * x2) * (1.f / 64.f) + NEPS);
            x1 = x1 * rstd * g[2 * li]; x2 = x2 * rstd * g[2 * li + 1];
            if (!isc) rope_apply(x1, x2, ang64);
            *p = pk2(x1, x2);
        }
#pragma unroll
        for (int s = 0; s < 10; ++s) {
            const bool isq = s < 8; if (isq && isc && l == 1) continue;
            unsigned* p = (unsigned*)(q + (isq ? GQ_OFF + s * 128 : GK_OFF + (s - 8) * 128)) + lane; const float* g = isq ? gqg : gkg;
            const unsigned w = *p; float x1 = bflo(w), x2 = bfhi(w);
            const float rstd = rsqrtf(wave_sum(x1 * x1 + x2 * x2) * (1.f / 128.f) + NEPS);
            x1 = x1 * rstd * g[2 * lane]; x2 = x2 * rstd * g[2 * lane + 1];
            if (!isc) rope_apply(x1, x2, ang128);
            *p = pk2(x1, x2);
        }
        { f32x2* p = (f32x2*)(q + RK_OFF) + lane; f32x2 w = *p; unsigned a = ((unsigned*)&w)[0], b2 = ((unsigned*)&w)[1];
          ((unsigned*)&w)[0] = pk2(bflo(a) * 0.125f, bfhi(a) * 0.125f); ((unsigned*)&w)[1] = pk2(bflo(b2) * 0.125f, bfhi(b2) * 0.125f); *p = w; }
    }
}
__device__ __forceinline__ void ret_state_item(const Args& A, const Frame& F, int l, int item) {
    using namespace att;
    const int vq = item & 3, dir = (item >> 2) & 1, h = (item >> 3) & 3, b = item >> 5;
    const bf16* QKV = (const bf16*)(A.ws + WS_QKV) + (size_t)b * TPB * INC;
    float* RST = (float*)(A.ws + WS_RST) + (size_t)((b * 4 + h) * 2 + dir) * NCHUNK * 64 * 128;
    const float lg = ((const float*)(A.ws + WS_SCAL))[l * 16 + 2 + dir * 4 + h];
    const float cdec = exp2f(lg * 128.f);
    int tq = F.tid; asm volatile("" : "+v"(tq));
    const int lane = tq & 63, wid = tq >> 6, r32 = lane & 31, hi = lane >> 5;
    char* lds = (char*)F.ldsg;
    const int krow = tq >> 3, kch = (tq & 7) * 8, vrow = (tq >> 2) & 63, vch = (tq & 3) * 8;
    const int kst = v_st(krow, kch), vst = v_st(vrow, vch);
    const int rdb = v_rd_base(lane);
    f32x16 acc = f32x16{};
    bf16x8 kreg, vreg;
#define RS_LOAD(tile) do { const bf16* rp = QKV + (size_t)((tile) * 64) * INC; kreg = *(const bf16x8*)(rp + (size_t)krow * INC + RK_OFF + h * 64 + kch); \
        if (tq < 256) vreg = *(const bf16x8*)(rp + (size_t)vrow * INC + RV_OFF + h * 128 + vq * 32 + vch); } while (0)
#define RS_WRITE(set, tile) do { const int jj = (((tile) & 1) * 64 + krow); const float w = exp2f(lg * (float)(dir == 0 ? 127 - jj : jj)); \
        const v4u kw = __builtin_bit_cast(v4u, kreg); v4u o; o.x = pk2(bflo(kw.x) * w, bfhi(kw.x) * w); o.y = pk2(bflo(kw.y) * w, bfhi(kw.y) * w); o.z = pk2(bflo(kw.z) * w, bfhi(kw.z) * w); o.w = pk2(bflo(kw.w) * w, bfhi(kw.w) * w); \
        *(LAS v4u*)(F.lds + (set) * 32768 + kst) = o; if (tq < 256) *(LAS bf16x8*)(F.lds + (set) * 32768 + 16384 + vst) = vreg; } while (0)
#define RS_CHUNK(st) (dir == 0 ? (st) : ((st) == 0 ? 1 : ((st) == 1 ? 0 : 19 - (st))))
    RS_LOAD(2 * RS_CHUNK(0)); asm volatile("s_waitcnt vmcnt(0)" ::: "memory"); RS_WRITE(0, 2 * RS_CHUNK(0));
    RS_LOAD(2 * RS_CHUNK(0) + 1);
    __syncthreads();
    for (int st = 0; st < NCHUNK; ++st) {
        const int C = RS_CHUNK(st);
        if (wid < 2) {
#pragma unroll
            for (int r = 0; r < 16; ++r) RST[((size_t)C * 64 + wid * 32 + crow(r, hi)) * 128 + vq * 32 + r32] = acc[r];
            acc = acc * cdec; }
#pragma unroll
        for (int t2 = 0; t2 < 2; ++t2) {
            const int set = t2;
            if (wid < 2) {
                const int kb = (int)(uintptr_t)(lds + set * 32768) + rdb, vb = kb + 16384;
                s16x4 kl[4], kh[4], vl[4], vh[4];
                if (wid == 0) {
                    kl[0] = tr_read<v_rd_off(0, 0, 0)>(kb); kh[0] = tr_read<v_rd_off(0, 0, 1)>(kb); kl[1] = tr_read<v_rd_off(0, 1, 0)>(kb); kh[1] = tr_read<v_rd_off(0, 1, 1)>(kb);
                    kl[2] = tr_read<v_rd_off(0, 2, 0)>(kb); kh[2] = tr_read<v_rd_off(0, 2, 1)>(kb); kl[3] = tr_read<v_rd_off(0, 3, 0)>(kb); kh[3] = tr_read<v_rd_off(0, 3, 1)>(kb);
                } else {
                    kl[0] = tr_read<v_rd_off(1, 0, 0)>(kb); kh[0] = tr_read<v_rd_off(1, 0, 1)>(kb); kl[1] = tr_read<v_rd_off(1, 1, 0)>(kb); kh[1] = tr_read<v_rd_off(1, 1, 1)>(kb);
                    kl[2] = tr_read<v_rd_off(1, 2, 0)>(kb); kh[2] = tr_read<v_rd_off(1, 2, 1)>(kb); kl[3] = tr_read<v_rd_off(1, 3, 0)>(kb); kh[3] = tr_read<v_rd_off(1, 3, 1)>(kb);
                }
                vl[0] = tr_read<v_rd_off(0, 0, 0)>(vb); vh[0] = tr_read<v_rd_off(0, 0, 1)>(vb); vl[1] = tr_read<v_rd_off(0, 1, 0)>(vb); vh[1] = tr_read<v_rd_off(0, 1, 1)>(vb);
                vl[2] = tr_read<v_rd_off(0, 2, 0)>(vb); vh[2] = tr_read<v_rd_off(0, 2, 1)>(vb); vl[3] = tr_read<v_rd_off(0, 3, 0)>(vb); vh[3] = tr_read<v_rd_off(0, 3, 1)>(vb);
                asm volatile("s_waitcnt lgkmcnt(0)" ::: "memory"); ATT_SBAR();
#define RS_PK(L, H) (bf16x8){L[0], L[1], L[2], L[3], H[0], H[1], H[2], H[3]}
#pragma unroll
                for (int ks = 0; ks < 4; ++ks) acc = __builtin_amdgcn_mfma_f32_32x32x16_bf16(RS_PK(kl[ks], kh[ks]), RS_PK(vl[ks], vh[ks]), acc, 0, 0, 0);
#undef RS_PK
            }
            const int idx = st * 2 + t2;
            if (idx + 1 < 2 * NCHUNK) { asm volatile("s_waitcnt vmcnt(0)" ::: "memory"); RS_WRITE((idx + 1) & 1, ((idx + 1) & 1) + 2 * RS_CHUNK((idx + 1) >> 1)); }
            if (idx + 2 < 2 * NCHUNK) RS_LOAD(2 * RS_CHUNK((idx + 2) >> 1) + ((idx + 2) & 1));
            __syncthreads();
        }
    }
#undef RS_LOAD
#undef RS_WRITE
#undef RS_CHUNK
}

constexpr int OST_OFF = 69632;
__device__ __forceinline__ void ost_flush(LAS unsigned char* wl, unsigned char* dst  , int lane) {
    asm volatile("s_waitcnt lgkmcnt(0)" ::: "memory");
#pragma unroll
    for (int i = 0; i < 4; ++i) { const int row = i * 8 + (lane >> 3), ch = (lane & 7) * 16; *(v4u*)(dst + (size_t)row * 2048 + ch) = *(const LAS v4u*)(wl + row * 128 + ch); }
    asm volatile("s_waitcnt lgkmcnt(0)" ::: "memory");
}
__device__ __forceinline__ void phase_attention(const Args& A, const Frame& F0, int l, int sel = 7) {
    const Frame F = refresh(F0);
    using namespace att;
    const bf16* QKV = (const bf16*)(A.ws + WS_QKV); unsigned char* CAT = A.ws + WS_CAT; float* DSC = (float*)(A.ws + WS_DSC);
    char* lds = (char*)F.ldsg;
    const float* scal = (const float*)(A.ws + WS_SCAL) + l * 16;
    const bool nomax_g = __builtin_amdgcn_readfirstlane(__float_as_int(scal[10])) != 0, nomax_d = __builtin_amdgcn_readfirstlane(__float_as_int(scal[11])) != 0;
    if (sel & 1) for (int it = F.vcu; it < 256; it += F.G) ret_state_item(A, F, l, it);
    const int n_gqa = (sel & 2) ? 512 + (l == 0 ? 64 : 0) : 0;
    const bool spread = F.G == 256 && l == 0;
    for (int i0 = F.vcu; i0 < n_gqa + ((spread && n_gqa > 0) ? 64 : 0); i0 += F.G) {
        int i = i0; if (spread && i0 >= 512) { i = i0 - 64; if (i < 512) continue; }
        int tq = F.tid; asm volatile("" : "+v"(tq)); const int lane = tq & 63, wid = tq >> 6, r32 = lane & 31, hi = lane >> 5;
        int b, j, qrow0, seq;
        if (i < 512) { const int ug = (i & 255) * 2 + (i >> 8), grp = ug >> 5, within = ug & 31; b = grp >> 1; j = (grp & 1) * 4 + (within >> 3); qrow0 = b * TPB + CTXL + (within & 7) * 256; seq = TPB; }
        else { const int u = i - 512; b = u >> 3; j = u & 7; qrow0 = b * TPB; seq = CTXL; }
        const bf16* Qb = QKV + (size_t)qrow0 * INC + GQ_OFF + j * 128;
        const bf16* Kh = QKV + (size_t)b * TPB * INC + GK_OFF + (j >> 2) * 128;
        const bf16* Vh = QKV + (size_t)b * TPB * INC + GV_OFF + (j >> 2) * 128;
        f32x16 o[4]; float rli[16];
        if (nomax_g) attn_body<128, true>(Qb, Kh, Vh, seq, lds, o, rli, tq); else attn_body<128, false>(Qb, Kh, Vh, seq, lds, o, rli, tq);
        { LAS unsigned char* wl = F.lds + OST_OFF + wid * 4096 + (4 * hi) * 128 + r32;
#pragma unroll
          for (int r = 0; r < 16; ++r) {
#pragma unroll
            for (int d0 = 0; d0 < 4; ++d0) wl[((r & 3) + 8 * (r >> 2)) * 128 + d0 * 32] = (unsigned char)f8x1((DBG & 2) ? o[d0][r] * rli[r] * GQA8_SCALE : 0.f); }
          ost_flush(F.lds + OST_OFF + wid * 4096, CAT + (size_t)(qrow0 + wid * 32) * 2048 + 512 + j * 128, lane); }
        __syncthreads();
    }
    const int n_diff = (sel & 4) ? 256 + (l == 0 ? 32 : 0) : 0;
    const float lam = scal[0], lam_init = scal[1];
    const float* dog = A.in[IN_DOG] + l * 128;
    for (int i0 = F.vcu; i0 < n_diff + ((spread && n_diff > 0) ? 128 : 0); i0 += F.G) {
        int i = i0; if (spread && i0 >= 256) { i = i0 - 128; if (i < 256) continue; }
        int tq = F.tid; asm volatile("" : "+v"(tq)); const int lane = tq & 63, wid = tq >> 6, r32 = lane & 31, hi = lane >> 5;
        int b, h, qrow0, seq;
        if (i < 256) { const int grp = i >> 3; b = grp >> 2; h = grp & 3; qrow0 = b * TPB + CTXL + (i & 7) * 256; seq = TPB; }
        else { const int u = i - 256; b = u >> 2; h = u & 3; qrow0 = b * TPB; seq = CTXL; }
        const bf16* Vh = QKV + (size_t)b * TPB * INC + DV_OFF + h * 128;
        const rsrc_t srr = mk_rsrc(DSC + (size_t)qrow0 * 512 + h * 128, 256 * 512 * 4); const unsigned slo = (unsigned)((wid * 32 + 4 * hi) * 512 + r32) * 4u;
        {
            f32x16 o[4]; float rli[16];
            if (nomax_d) attn_body<64, true>(QKV + (size_t)qrow0 * INC + DQ_OFF + h * 128, QKV + (size_t)b * TPB * INC + DK_OFF + h * 128, Vh, seq, lds, o, rli, tq);
            else attn_body<64, false>(QKV + (size_t)qrow0 * INC + DQ_OFF + h * 128, QKV + (size_t)b * TPB * INC + DK_OFF + h * 128, Vh, seq, lds, o, rli, tq);
#pragma unroll
            for (int r = 0; r < 16; ++r) {
#pragma unroll
                for (int d0 = 0; d0 < 4; ++d0) BST32F(o[d0][r] * rli[r], srr, slo, (((r & 3) + 8 * (r >> 2)) * 512 + d0 * 32) * 4); }
            __syncthreads();
        }
        {
            f32x16 o[4]; float rli[16];
            if (nomax_d) attn_body<64, true>(QKV + (size_t)qrow0 * INC + DQ_OFF + h * 128 + 64, QKV + (size_t)b * TPB * INC + DK_OFF + h * 128 + 64, Vh, seq, lds, o, rli, tq);
            else attn_body<64, false>(QKV + (size_t)qrow0 * INC + DQ_OFF + h * 128 + 64, QKV + (size_t)b * TPB * INC + DK_OFF + h * 128 + 64, Vh, seq, lds, o, rli, tq);
            LAS unsigned char* wl = F.lds + OST_OFF + wid * 4096 + (4 * hi) * 128 + r32;
            float gv[4];
#pragma unroll
            for (int d0 = 0; d0 < 4; ++d0) gv[d0] = dog[d0 * 32 + r32] * (1.f - lam_init);
#pragma unroll
            for (int rg = 0; rg < 4; ++rg) { float d0v[4][4];
#pragma unroll
                for (int q = 0; q < 4; ++q)
#pragma unroll
                    for (int d0 = 0; d0 < 4; ++d0) { const int r = rg * 4 + q; d0v[q][d0] = BLD32F(srr, slo, (((r & 3) + 8 * (r >> 2)) * 512 + d0 * 32) * 4); }
                __builtin_amdgcn_sched_barrier(0);
#pragma unroll
                for (int q = 0; q < 4; ++q) { const int r = rg * 4 + q; float dv[4]; float ss = 0.f;
#pragma unroll
                    for (int d0 = 0; d0 < 4; ++d0) { dv[d0] = d0v[q][d0] - lam * (o[d0][r] * rli[r]); ss += dv[d0] * dv[d0]; }
                    const float rstd = rsqrtf(half_sum32(ss) * (1.f / 128.f) + NEPS);
#pragma unroll
                    for (int d0 = 0; d0 < 4; ++d0) wl[((r & 3) + 8 * (r >> 2)) * 128 + d0 * 32] = (unsigned char)f8x1((DBG & 1) ? dv[d0] * rstd * gv[d0] : 0.f); }
                __builtin_amdgcn_sched_barrier(0); }
            ost_flush(F.lds + OST_OFF + wid * 4096, CAT + (size_t)(qrow0 + wid * 32) * 2048 + h * 128, lane);
            __syncthreads();
        }
    }
}

__device__ __forceinline__ void phase_retention_out(const Args& A, const Frame& F0, int l) {
    const Frame F = refresh(F0);
    using namespace att;
    const bf16* QKV = (const bf16*)(A.ws + WS_QKV); unsigned char* CAT = A.ws + WS_CAT;
    char* lds = (char*)F.ldsg;
    const float* scal = (const float*)(A.ws + WS_SCAL) + l * 16;
    const float* rog = A.in[IN_ROG] + l * 128;
    const int nP = l == 0 ? 9 : 8, nU = 32 * nP;
    for (int u = F.vcu; u < nU; u += F.G) {
        int tq = F.tid; asm volatile("" : "+v"(tq));
        const int tid = tq, lane = tq & 63, wid = tq >> 6, r32 = lane & 31, hi = lane >> 5;
        const int sr = tq >> 4, sc = (tq & 15) * 8, kr = tq >> 3, kc = (tq & 7) * 8;
        const int vb0 = (int)(uintptr_t)lds + v_rd_base(tq & 63);
        const int P = u % nP + (l == 0 ? 0 : 1), bh = u / nP, h = bh & 3, b = bh >> 2;
        const int R0 = b * TPB + P * 256;
        const float lgf = scal[2 + h], lgb = scal[6 + h];
#pragma unroll 1
        for (int t = 0; t < 4; ++t) {
            const bf16* rp = QKV + (size_t)(R0 + t * 64) * INC;
            const bf16x8 v0 = *(const bf16x8*)(rp + (size_t)sr * INC + RV_OFF + h * 128 + sc), v1 = *(const bf16x8*)(rp + (size_t)(32 + sr) * INC + RV_OFF + h * 128 + sc);
            const bf16x8 k0 = *(const bf16x8*)(rp + (size_t)kr * INC + RK_OFF + h * 64 + kc);
            *(bf16x8*)(lds + t * 16384 + v_st(sr, sc)) = v0; *(bf16x8*)(lds + t * 16384 + v_st(32 + sr, sc)) = v1;
            *(bf16x8*)(lds + 65536 + t * 8192 + koff<64>(kr, kc * 2)) = k0;
        }
        bf16x8 qr[4];
        { const bf16* Qw = QKV + (size_t)(R0 + wid * 32 + r32) * INC + RQ_OFF + h * 64 + hi * 8;
#pragma unroll
          for (int d0 = 0; d0 < 4; ++d0) qr[d0] = *(const bf16x8*)(Qw + d0 * 16); }
        __syncthreads();
        const int cp = wid >> 2; int ipos = (wid & 3) * 32 + r32; asm volatile("" : "+v"(ipos));
        int hiv = hi; asm volatile("" : "+v"(hiv));
        f32x16 o[4];
#pragma unroll
        for (int d = 0; d < 4; ++d) o[d] = f32x16{};
#pragma unroll
        for (int t2 = 0; t2 < 2; ++t2) {
            const int t = cp * 2 + t2;
            f32x16 p0, p1; qkt<64>(p0, p1, lds + 65536 + t * 8192, qr, r32, hi);
#pragma unroll
            for (int r = 0; r < 16; ++r) { const int j0 = t2 * 64 + crow(r, hiv), d0_ = ipos - j0, d1_ = d0_ - 32;
                p0[r] *= d0_ >= 0 ? exp2f(lgf * (float)d0_) : exp2f(lgb * (float)(-d0_));
                p1[r] *= d1_ >= 0 ? exp2f(lgf * (float)d1_) : exp2f(lgb * (float)(-d1_)); }
            bf16x8 pa0, pa1, pa2, pa3;
            ATT_PK4(p0, 0, pa0); ATT_PK4(p0, 8, pa1); ATT_PK4(p1, 0, pa2); ATT_PK4(p1, 8, pa3);
            pv_d0(o, vb0 + t * 16384, pa0, pa1, pa2, pa3);
        }
        __syncthreads();
        { const int d = tid >> 3, v0 = (tid & 7) * 16;
#pragma unroll 1
          for (int img = 0; img < 4; ++img) { const int cpi = img >> 1, dir = img & 1, C = 2 * P + cpi;
              const float* sp = (const float*)(A.ws + WS_RST) + ((size_t)(((b * 4 + h) * 2 + dir) * NCHUNK + C) * 64 + d) * 128 + v0;
              const f32x4 a = *(const f32x4*)(sp), bq = *(const f32x4*)(sp + 4), c = *(const f32x4*)(sp + 8), e = *(const f32x4*)(sp + 12);
              v4u w0, w1; w0.x = pk2(a.x, a.y); w0.y = pk2(a.z, a.w); w0.z = pk2(bq.x, bq.y); w0.w = pk2(bq.z, bq.w);
              w1.x = pk2(c.x, c.y); w1.y = pk2(c.z, c.w); w1.z = pk2(e.x, e.y); w1.w = pk2(e.z, e.w);
              *(v4u*)(lds + img * 16384 + v_st(d, v0)) = w0; *(v4u*)(lds + img * 16384 + v_st(d, v0 + 8)) = w1; } }
        __syncthreads();
#pragma unroll
        for (int dir = 0; dir < 2; ++dir) {
            const float qs = dir == 0 ? exp2f(lgf * (float)(ipos + 1)) : exp2f(lgb * (float)(128 - ipos));
            bf16x8 pa[4];
#pragma unroll
            for (int ks = 0; ks < 4; ++ks) { v4u w = __builtin_bit_cast(v4u, qr[ks]);
                w.x = pk2(bflo(w.x) * qs, bfhi(w.x) * qs); w.y = pk2(bflo(w.y) * qs, bfhi(w.y) * qs); w.z = pk2(bflo(w.z) * qs, bfhi(w.z) * qs); w.w = pk2(bflo(w.w) * qs, bfhi(w.w) * qs);
                pa[ks] = __builtin_bit_cast(bf16x8, w); }
            pv_d0(o, vb0 + (cp * 2 + dir) * 16384, pa[0], pa[1], pa[2], pa[3]);
        }
        { const rsrc_t grr = mk_rsrc(QKV + (size_t)R0 * INC + RG_OFF + h * 128, 256 * INC * 2); const unsigned glo = (unsigned)((wid * 32 + 4 * hi) * INC + r32) * 2u;
          LAS unsigned char* wl = F.lds + 98304 + wid * 4096 + (4 * hi) * 128 + r32;
          float gv[4];
#pragma unroll
          for (int d0 = 0; d0 < 4; ++d0) gv[d0] = rog[d0 * 32 + r32];
#define RG_LOAD(G_, rg_) do { _Pragma("unroll") for (int q = 0; q < 4; ++q) _Pragma("unroll") for (int d0 = 0; d0 < 4; ++d0) { const int r = (rg_) * 4 + q; G_[q][d0] = BLD16(grr, glo, (((r & 3) + 8 * (r >> 2)) * INC + d0 * 32) * 2); } } while (0)
          unsigned short gtn[4][4]; RG_LOAD(gtn, 0);
#pragma unroll
          for (int rg = 0; rg < 4; ++rg) {
              unsigned short gtw[4][4];
#pragma unroll
              for (int q = 0; q < 4; ++q)
#pragma unroll
                  for (int d0 = 0; d0 < 4; ++d0) gtw[q][d0] = gtn[q][d0];
              if (rg < 3) RG_LOAD(gtn, rg + 1);
              __builtin_amdgcn_sched_barrier(0);
#pragma unroll
              for (int q = 0; q < 4; ++q) { const int r = rg * 4 + q; float ss = 0.f;
#pragma unroll
                  for (int d0 = 0; d0 < 4; ++d0) ss += o[d0][r] * o[d0][r];
                  const float rstd = rsqrtf(half_sum32(ss) * (1.f / 128.f) + NEPS);
#pragma unroll
                  for (int d0 = 0; d0 < 4; ++d0) { const float y = o[d0][r] * rstd * gv[d0]; const float gt = bf2f(gtw[q][d0]);
                      wl[((r & 3) + 8 * (r >> 2)) * 128 + d0 * 32] = (unsigned char)f8x1((DBG & 4) ? siluf(gt) * y : 0.f); } }
              asm volatile("" ::: "memory"); }
#undef RG_LOAD
          ost_flush(F.lds + 98304 + wid * 4096, CAT + (size_t)(R0 + wid * 32) * 2048 + 1536 + h * 128, lane); }
        __syncthreads();
    }
}
#ifndef DBG_CHECK
#define DBG_CHECK 0
#endif
constexpr size_t WS_CHK = 880 * MiB;
constexpr int CHK_NT = 64;
__device__ __forceinline__ int chk_row(int i) { return 37 * i * 7 + 261; }
__device__ __forceinline__ void chk_fail(const Args& A, int k) { atomicAdd((unsigned*)(A.ws + WS_CTL) + 512 + k, 1u); }
__device__ __forceinline__ float gelu_exact(float z) { return 0.5f * z * (1.f + erff(z * 0.70710678118654752f)); }
__device__ __forceinline__ void chk_save(const Args& A, int tid) {
    float* SH = (float*)(A.ws + WS_CHK); float* SX = SH + CHK_NT * 2048;
    const bf16* HN = (const bf16*)(A.ws + WS_HN); const bf16* XS = (const bf16*)(A.ws + WS_XS);
    for (int i = tid; i < CHK_NT * 2048; i += NTHR) { const int s = i >> 11, c = i & 2047, R = chk_row(s); SH[i] = bf2f(HN[(size_t)R * 2048 + c]); SX[i] = bf2f(XS[(size_t)R * 2048 + c]); }
}
__device__ __forceinline__ void chk_qp_topk(const Args& A, int tid) {
    const float* SH = (const float*)(A.ws + WS_CHK);
    const bf16* QP = (const bf16*)(A.ws + WS_QKV);
    const float* WQ = A.in[IN_PWQ];
    { const int s = tid >> 3, cc = (tid & 7) * 251 + 3, R = chk_row(s); float acc = 0.f;
      for (int k = 0; k < 2048; ++k) acc += SH[s * 2048 + k] * WQ[(size_t)k * 2048 + cc];
      const float got = bf2f(QP[pg8::qp_frag_index(R, cc)]);
      if (!(fabsf(got - acc) <= 0.02f * fabsf(acc) + 0.05f)) chk_fail(A, 1); }
    { const int s = tid >> 3, h = tid & 7, R = chk_row(s);
      float* sc = (float*)(A.ws + WS_CHK) + 4 * CHK_NT * 2048 + (size_t)tid * 1024;
      const float* SKf = A.in[IN_PSK] + (size_t)h * 2 * 128 * 128;
      for (int p = 0; p < 2; ++p) for (int k = 0; k < 128; ++k) { float a = 0.f;
          for (int d = 0; d < 128; ++d) a += bf2f(QP[pg8::qp_frag_index(R, h * 256 + p * 128 + d)]) * SKf[(size_t)(p * 128 + k) * 128 + d];
          sc[p * 128 + k] = a; }
      float* tv = sc + 256; float* cs = sc + 320;
      for (int p = 0; p < 2; ++p) for (int t = 0; t < 16; ++t) { int bi = 0; float bv = -INFINITY;
          for (int k = 0; k < 128; ++k) if (sc[p * 128 + k] > bv) { bv = sc[p * 128 + k]; bi = k; }
          tv[p * 16 + t] = bv; tv[32 + p * 16 + t] = (float)bi; sc[p * 128 + bi] = -INFINITY; }
      for (int a = 0; a < 16; ++a) for (int b2 = 0; b2 < 16; ++b2) cs[a * 16 + b2] = tv[a] + tv[16 + b2];
      const int* ip = (const int*)(A.ws + WS_PIDX) + (size_t)R * 128 + h * 16; const float* gp = (const float*)(A.ws + WS_PGATE) + (size_t)R * 128 + h * 16;
      int miss = 0; float gsum = 0.f;
      for (int t = 0; t < 16; ++t) { int bi = 0; float bv = -INFINITY;
          for (int k = 0; k < 256; ++k) if (cs[k] > bv) { bv = cs[k]; bi = k; }
          cs[bi] = -INFINITY; const int id = (int)tv[32 + (bi >> 4)] * 128 + (int)tv[48 + (bi & 15)];
          bool found = false; for (int q = 0; q < 16; ++q) found |= ip[q] == id;
          if (!found) ++miss; }
      for (int q = 0; q < 16; ++q) { gsum += gp[q]; if (!(ip[q] >= 0 && ip[q] < NEXP)) miss += 100; }
      if (miss > 3) chk_fail(A, 2);
      if (!(fabsf(gsum - 1.f) < 1e-3f)) chk_fail(A, 3); }
}
__device__ __forceinline__ void chk_experts(const Args& A, int tid) {
    const float* SH = (const float*)(A.ws + WS_CHK); const float* SX = SH + CHK_NT * 2048;
    float* ACT = (float*)(A.ws + WS_CHK) + 2 * CHK_NT * 2048;
    const float* U = A.in[IN_PU]; const float* V = A.in[IN_PV];
    for (int i = tid; i < CHK_NT * 128; i += NTHR) { const int s = i >> 7, e = i & 127, R = chk_row(s);
        const int id = ((const int*)(A.ws + WS_PIDX))[(size_t)R * 128 + e]; const float g = ((const float*)(A.ws + WS_PGATE))[(size_t)R * 128 + e];
        float z = 0.f; for (int k = 0; k < 2048; ++k) z += SH[s * 2048 + k] * U[(size_t)id * 2048 + k];
        ACT[i] = gelu_exact(z) * g; }
    __syncthreads(); __threadfence_block();
    { const int s = tid >> 3, cc = (tid & 7) * 251 + 5, R = chk_row(s), b = R / TPB; const bool isc = (R % TPB) < CTXL;
      float o = 0.f; for (int e = 0; e < 128; ++e) { const int id = ((const int*)(A.ws + WS_PIDX))[(size_t)R * 128 + e]; o += ACT[s * 128 + e] * V[(size_t)id * 2048 + cc]; }
      const float g2 = ((const float*)(A.ws + WS_MOD))[(size_t)(isc ? 8 : b) * 12288 + 5 * 2048 + cc];
      const float want = SX[s * 2048 + cc] + g2 * o, got = bf2f(((const bf16*)(A.ws + WS_XS))[(size_t)R * 2048 + cc]);
      if (!(fabsf(got - want) <= 0.06f * fabsf(g2 * o) + 0.03f + 0.01f * fabsf(want))) chk_fail(A, 4); }
}
__device__ __forceinline__ float chk_code(const Args& A) {
    const unsigned* e = (const unsigned*)(A.ws + WS_CTL) + 512;
    for (int k = 1; k < 8; ++k) if (__hip_atomic_load(e + k, __ATOMIC_RELAXED, __HIP_MEMORY_SCOPE_AGENT)) return (float)k;
    return 0.f;
}
typedef float f32x16 __attribute__((ext_vector_type(16)));
__device__ __forceinline__ float swap_max(float m) { auto rr = __builtin_amdgcn_permlane32_swap(__float_as_uint(m), __float_as_uint(m), false, false); return fmaxf(__uint_as_float(rr[0]), __uint_as_float(rr[1])); }
__device__ __forceinline__ int peer_row(int l, int idx) { return l == 0 ? idx : (idx >> 11) * TPB + CTXL + (idx & 2047); }
#define PT_CE(x, y) do { const float mx_ = fmaxf(x, y), mn_ = fminf(x, y); x = mx_; y = mn_; } while (0)
template <class V> __device__ __forceinline__ void pt_sort16(V& v) {
#pragma unroll
    for (int k = 2; k <= 16; k <<= 1)
#pragma unroll
        for (int j = k >> 1; j > 0; j >>= 1)
#pragma unroll
            for (int i = 0; i < 16; ++i) { const int p = i ^ j; if (p > i) { if ((i & k) == 0) { float a = v[i], b = v[p]; PT_CE(a, b); v[i] = a; v[p] = b; } else { float a = v[p], b = v[i]; PT_CE(a, b); v[p] = a; v[i] = b; } } }
}
template <class V> __device__ __forceinline__ void pt_merge16(V& v) {
#pragma unroll
    for (int j = 8; j > 0; j >>= 1)
#pragma unroll
        for (int i = 0; i < 16; ++i) { const int p = i ^ j; if (p > i) { float a = v[i], b = v[p]; PT_CE(a, b); v[i] = a; v[p] = b; } }
}
template <class V, class W> __device__ __forceinline__ void pt_top16(V& a, const W& b) {
#pragma unroll
    for (int i = 0; i < 16; ++i) a[i] = fmaxf(a[i], b[15 - i]);
    pt_merge16(a);
}
__device__ __forceinline__ void peer_topk_task(const Args& A, int l, int R0, int h, int lane, LAS unsigned* wscr, const LAS unsigned char* skl  ) {
    asm volatile("" : "+v"(lane));
    const int n = lane & 31; int hi = lane >> 5; asm volatile("" : "+v"(hi));
    const bf16* QP = (const bf16*)(A.ws + WS_QKV);
    const bf16* SK = (const bf16*)(A.ws + WS_SUBK) + (size_t)(l * 8 + h) * 2 * 128 * 128;
    f32x16 sel[2];
    bf16x8 qfa[2][8];
#pragma unroll
    for (int p = 0; p < 2; ++p) { const bf16* qp = QP + ((((size_t)(R0 >> 5) * 8 + h) * 2 + p) * 8 * 2 * 32 + lane) * 8;
#pragma unroll
        for (int ks = 0; ks < 8; ++ks) qfa[p][ks] = *(const bf16x8*)(qp + ks * 512); }
#pragma unroll
    for (int p = 0; p < 2; ++p) {
        bf16x8 qf[8];
#pragma unroll
        for (int ks = 0; ks < 8; ++ks) qf[ks] = qfa[p][ks];
        f32x16 sc[4];
#pragma unroll
        for (int kb = 0; kb < 4; ++kb) { sc[kb] = f32x16{};
            const bf16* kp = SK + ((size_t)(p * 4 + kb) * 8 * 2 * 32 + lane) * 8;
            if (skl) { const LAS unsigned char* kl = skl + ((size_t)(p * 4 + kb) * 8 * 2 * 32 + lane) * 16;
#pragma unroll
                for (int ks = 0; ks < 8; ++ks) sc[kb] = __builtin_amdgcn_mfma_f32_32x32x16_bf16(*(const LAS bf16x8*)(kl + ks * 1024), qf[ks], sc[kb], 0, 0, 0); }
            else {
#pragma unroll
                for (int ks = 0; ks < 8; ++ks) sc[kb] = __builtin_amdgcn_mfma_f32_32x32x16_bf16(*(const bf16x8*)(kp + ks * 512), qf[ks], sc[kb], 0, 0, 0); }
            __builtin_amdgcn_sched_barrier(0); }
#pragma unroll
        for (int kb = 0; kb < 4; ++kb)
#pragma unroll
            for (int r = 0; r < 16; ++r) { const unsigned key = (unsigned)(kb * 32 + (r & 3) + 8 * (r >> 2) + 4 * hi); sc[kb][r] = __uint_as_float((__float_as_uint(sc[kb][r]) & ~127u) | key); }
        pt_sort16(sc[0]); pt_sort16(sc[1]); pt_sort16(sc[2]); pt_sort16(sc[3]);
        pt_top16(sc[0], sc[1]); pt_top16(sc[2], sc[3]); pt_top16(sc[0], sc[2]);
        f32x16 pb;
#pragma unroll
        for (int i = 0; i < 16; ++i) { auto rr = __builtin_amdgcn_permlane32_swap(__float_as_uint(sc[0][i]), __float_as_uint(sc[0][i]), false, false); pb[i] = __uint_as_float(hi ? rr[0] : rr[1]); }
        pt_top16(sc[0], pb);
        sel[p] = sc[0];
    }
    f32x16 cd[4];
#pragma unroll
    for (int g = 0; g < 4; ++g)
#pragma unroll
        for (int i = 0; i < 16; ++i) cd[g][i] = -INFINITY;
    { int c = 0;
#pragma unroll
      for (int a = 0; a < 16; ++a)
#pragma unroll
          for (int b2 = 0; b2 < 16; ++b2) if ((a + 1) * (b2 + 1) <= 16) { cd[c >> 4][c & 15] = __uint_as_float((__float_as_uint(sel[0][a] + sel[1][b2]) & ~255u) | (unsigned)(a * 16 + b2)); ++c; } }
    pt_sort16(cd[0]); pt_sort16(cd[1]); pt_sort16(cd[2]); pt_sort16(cd[3]);
    pt_top16(cd[0], cd[1]); pt_top16(cd[2], cd[3]); pt_top16(cd[0], cd[2]);
#pragma unroll
    for (int q = 0; q < 16; ++q) { wscr[q * 64 + lane] = __float_as_uint(sel[0][q]) & 127u; wscr[(16 + q) * 64 + lane] = __float_as_uint(sel[1][q]) & 127u; }
    float e[16], es = 0.f; int ids[16];
#pragma unroll
    for (int t = 0; t < 16; ++t) { const unsigned bits = __float_as_uint(cd[0][t]) & 255u; const unsigned a = bits >> 4, b2 = bits & 15u;
        ids[t] = (int)(wscr[a * 64 + lane] * 128u + wscr[(16 + b2) * 64 + lane]); e[t] = __expf(cd[0][t] - cd[0][0]); es += e[t]; }
    const float inv = 1.f / es;
    if (hi == 0) {
        int* ip = (int*)(A.ws + WS_PIDX) + (size_t)(R0 + n) * 128 + h * 16; float* gp = (float*)(A.ws + WS_PGATE) + (size_t)(R0 + n) * 128 + h * 16;
#pragma unroll
        for (int t = 0; t < 16; ++t) { ip[t] = ids[t]; gp[t] = e[t] * inv; }
    }
}
__device__ __forceinline__ void phase_peer_topk(const Args& A, const Frame& F0, int l) {
    const Frame F = refresh(F0);
    const int ngrp = (l == 0 ? MROWS : NB * SEQL) / 32;
    if (F.G % 8 == 0) {
        const int h = F.vcu & 7, wq = F.wave * (F.G >> 3) + (F.vcu >> 3), nwq = (F.G >> 3) * NWAVES;
        { const v4u* src = (const v4u*)((const bf16*)(A.ws + WS_SUBK) + (size_t)(l * 8 + h) * 2 * 128 * 128);
#pragma unroll
          for (int i = 0; i < 8; ++i) *(LAS v4u*)(F.lds + 65536 + (i * NTHR + F.tid) * 16) = src[i * NTHR + F.tid]; }
        __syncthreads();
        for (int tg = wq; tg < ngrp; tg += nwq) peer_topk_task(A, l, peer_row(l, tg * 32), h, F.lane, (LAS unsigned*)(F.lds + F.wave * 8192), F.lds + 65536);
    } else {
        const int gw = F.vcu * NWAVES + F.wave, NGW = F.G * NWAVES;
        for (int tk = gw; tk < ngrp * 8; tk += NGW) { const int tg = tk >> 3, h = tk & 7; peer_topk_task(A, l, peer_row(l, tg * 32), h, F.lane, (LAS unsigned*)(F.lds + F.wave * 8192), nullptr); }
    }
}

constexpr int NGRP = 16;
__device__ __forceinline__ float gelu_erf(float z) { return 0.5f * z * (1.f + erff(z * 0.70710678118654752f)); }
__device__ __forceinline__ int sdot16(const v4u a, const v4u b, int acc) {
    const unsigned a0 = a.x, a1 = a.y, a2 = a.z, a3 = a.w, b0 = b.x, b1 = b.y, b2 = b.z, b3 = b.w;
    acc = __builtin_amdgcn_sdot4((int)a0, (int)b0, acc, false); acc = __builtin_amdgcn_sdot4((int)a1, (int)b1, acc, false);
    acc = __builtin_amdgcn_sdot4((int)a2, (int)b2, acc, false); acc = __builtin_amdgcn_sdot4((int)a3, (int)b3, acc, false);
    return acc;
}
typedef int i32x4v __attribute__((ext_vector_type(4)));
typedef int i32x8v __attribute__((ext_vector_type(8)));
typedef int i32x2v __attribute__((ext_vector_type(2)));
constexpr int NGRP_U = 4, GRP_U_SHIFT = 12;
__device__ __forceinline__ void phase_peer_u(const Args& A, const Frame& F0, int l, int pmode = 0) {
    const Frame F = refresh(F0);
    const int lane = F.lane;
    const int amask = pmode == 1 ? 63 : 0xFFFF;
    const bool pr8 = F.pnx == 8;
    const int nvx = pr8 ? 4 : F.pnx, vx = pr8 ? (F.px & 3) : F.px, rank = pr8 ? F.prank * 2 + (F.px >> 2) : F.prank, nrank = pr8 ? F.pcnt * 2 : F.pcnt;
    const int ntok = l == 0 ? MROWS : NB * SEQL;
    const unsigned char* U4 = A.ws + WS_U8 + (size_t)l * NEXP * 1024;
    const rsrc_t urs = mk_rsrc(U4, (unsigned)NEXP * 1024u);
    const f32x2* UVS = (const f32x2*)(A.ws + WS_US) + l * NEXP;
    const signed char* H8 = (const signed char*)(A.ws + WS_H8); const float* HS = (const float*)(A.ws + WS_HS);
    const int* PIDX = (const int*)(A.ws + WS_PIDX); const float* PGATE = (const float*)(A.ws + WS_PGATE); unsigned* ACT = (unsigned*)(A.ws + WS_ACT);
    const int kg = lane >> 4, e4 = (lane >> 2) & 3, sl4 = lane & 3;
    const unsigned lbyte = (unsigned)(kg * 64 + sl4 * 16);
    const unsigned hbyte = (unsigned)(kg * 128 + sl4 * 32);
    const int eL = 4 * e4 + kg;
    const bool epi_lane = sl4 == 0;
    LAS unsigned* list = (LAS unsigned*)(F.lds + F.wave * 5120);
    LAS unsigned char* hb = F.lds + F.wave * 5120 + 1024;
    const int stride = nrank * NWAVES, t0 = rank * NWAVES + F.wave;
    constexpr unsigned OOB = 0x80000000u;
    for (int g = vx; g < NGRP_U; g += nvx) {
        int tcur = t0 - stride;
        int nR = peer_row(l, t0 < ntok ? t0 : 0);
        int nidA, nidB; { const i32x2v t_ = *(const i32x2v*)(PIDX + (size_t)nR * 128 + 2 * lane); nidA = t_.x; nidB = t_.y; }
        v4u nh0 = *(const v4u*)(H8 + (size_t)nR * 2048 + lane * 16), nh1 = *(const v4u*)(H8 + (size_t)nR * 2048 + 1024 + lane * 16);
        float nhs = HS[nR];
        int par = 0, bi = 0, cnt = 0, R = 0; float hs = 0.f;
        int cR, cpar, cent; float chs; unsigned cv0, cv1, cv2, cv3; bool clive;
        int xR, xpar, xent; float xhs; unsigned xv0, xv1, xv2, xv3; bool xlive;
#define U_VO(qd) ({ const int ix_ = bi * 16 + 4 * (qd) + e4; const unsigned e_ = list[par * 128 + (ix_ & 127)]; \
                    ix_ < cnt ? (unsigned)((int)(e_ & 0xffffu) & amask) * 1024u + lbyte : OOB; })
#define U_SETUP() do { \
        if ((bi + 1) * 16 < cnt) ++bi; \
        else { tcur += stride; bi = 0; par ^= 1; R = nR; hs = nhs; \
            *(LAS v4u*)(hb + par * 2048 + lane * 16) = nh0; *(LAS v4u*)(hb + par * 2048 + 1024 + lane * 16) = nh1; \
            const bool ex_ = tcur < ntok; \
            const bool inA = ex_ && (nidA >> GRP_U_SHIFT) == g, inB = ex_ && (nidB >> GRP_U_SHIFT) == g; \
            const unsigned long long balA = __ballot(inA), balB = __ballot(inB); \
            const int cntA = __builtin_popcountll(balA); cnt = cntA + __builtin_popcountll(balB); \
            const int posA = (int)__builtin_amdgcn_mbcnt_hi((unsigned)(balA >> 32), __builtin_amdgcn_mbcnt_lo((unsigned)balA, 0u)); \
            const int posB = cntA + (int)__builtin_amdgcn_mbcnt_hi((unsigned)(balB >> 32), __builtin_amdgcn_mbcnt_lo((unsigned)balB, 0u)); \
            if (inA) list[par * 128 + posA] = (unsigned)nidA | ((unsigned)(2 * lane) << 16); \
            if (inB) list[par * 128 + posB] = (unsigned)nidB | ((unsigned)(2 * lane + 1) << 16); \
            { const int tq = tcur + stride < ntok ? tcur + stride : 0; nR = peer_row(l, tq);       \
              { const i32x2v t_ = *(const i32x2v*)(PIDX + (size_t)nR * 128 + 2 * lane); nidA = t_.x; nidB = t_.y; } \
              nh0 = *(const v4u*)(H8 + (size_t)nR * 2048 + lane * 16); nh1 = *(const v4u*)(H8 + (size_t)nR * 2048 + 1024 + lane * 16); nhs = HS[nR]; } } \
        xlive = tcur < ntok; \
        xR = R; xhs = hs; xpar = par; \
        xv0 = U_VO(0); xv1 = U_VO(1); xv2 = U_VO(2); xv3 = U_VO(3); \
        const unsigned e1 = list[par * 128 + ((bi * 16 + eL) & 127)]; \
        xent = (epi_lane && bi * 16 + eL < cnt) ? (int)e1 : -1; } while (0)
#define U_BLOADS(B, va, vb) do { _Pragma("unroll") for (int c = 0; c < 4; ++c) { B[c] = BLD128(urs, (va) + (unsigned)(c * 256), 0); B[4 + c] = BLD128(urs, (vb) + (unsigned)(c * 256), 0); } } while (0)
#define U_MFMA(B, ho, accA, accB) do { _Pragma("unroll") for (int c = 0; c < 4; ++c) { \
            const i32x4v hlo = *(const LAS i32x4v*)(hb + (ho) + c * 512 + hbyte2), hhi = *(const LAS i32x4v*)(hb + (ho) + c * 512 + hbyte2 + 256); \
            const i32x8v hv = {hlo.x, hlo.y, hlo.z, hlo.w, hhi.x, hhi.y, hhi.z, hhi.w}; \
            asm volatile("v_mfma_scale_f32_16x16x128_f8f6f4 %0, %1, %2, %0, %3, %4 op_sel_hi:[0,0,0] cbsz:4" : "+v"(accA) : "v"(B[c]), "v"(hv), "v"(sc1), "v"(sc1)); \
            asm volatile("v_mfma_scale_f32_16x16x128_f8f6f4 %0, %1, %2, %0, %3, %4 op_sel_hi:[0,0,0] cbsz:4" : "+v"(accB) : "v"(B[4 + c]), "v"(hv), "v"(sc1), "v"(sc1)); } } while (0)
        const unsigned hbyte2 = (unsigned)((kg >> 1) * 128 + sl4 * 32 + (kg & 1) * 16);
        int sc1 = 127; asm volatile("" : "+v"(sc1));
        v4u b0[8], b1[8];
        U_SETUP();
        clive = xlive; cR = xR; cpar = xpar; cent = xent; chs = xhs; cv0 = xv0; cv1 = xv1; cv2 = xv2; cv3 = xv3;
#pragma unroll
        for (int c = 0; c < 4; ++c) { b0[c] = BLD128(urs, cv0 + (unsigned)(c * 256), 0); __builtin_amdgcn_sched_barrier(0); b0[4 + c] = BLD128(urs, cv1 + (unsigned)(c * 256), 0); __builtin_amdgcn_sched_barrier(0); }
        while (clive) {
            U_BLOADS(b1, cv2, cv3);
            __builtin_amdgcn_sched_barrier(0);
            const int rw = cent >= 0 ? (cent & 0xffff) : 0, slot = cent >= 0 ? (cent >> 16) : 0;
            const f32x2 uvs = UVS[rw]; const float gate = PGATE[(size_t)cR * 128 + slot]; const float us = uvs.x, vs = uvs.y;
            f32x4 a0 = {0.f, 0.f, 0.f, 0.f}, a1 = {0.f, 0.f, 0.f, 0.f}, a2 = {0.f, 0.f, 0.f, 0.f}, a3 = {0.f, 0.f, 0.f, 0.f};
            U_MFMA(b0, cpar * 2048, a0, a1);
            U_SETUP();
            U_BLOADS(b0, xlive ? xv0 : OOB, xlive ? xv1 : OOB);
            __builtin_amdgcn_sched_barrier(0);
            U_MFMA(b1, cpar * 2048, a2, a3);
            asm volatile("s_nop 15\n\ts_nop 15" ::: "memory");
            {
              const f32x4 aq = e4 == 0 ? a0 : (e4 == 1 ? a1 : (e4 == 2 ? a2 : a3));
              float w = sl4 == 0 ? aq.x : (sl4 == 1 ? aq.y : (sl4 == 2 ? aq.z : aq.w));
              w += __shfl_xor(w, 1); w += __shfl_xor(w, 2);
              if (cent >= 0) {
                const float av = gelu_erf(w * us * chs) * gate * vs;
                ACT[(size_t)cR * 128 + (slot & 7) * 16 + (slot >> 3)] = (pk2(0.f, av) & 0xffff0000u) | (unsigned)rw; } }
            clive = xlive; cR = xR; cpar = xpar; cent = xent; chs = xhs; cv0 = xv0; cv1 = xv1; cv2 = xv2; cv3 = xv3;
        }
#undef U_VO
#undef U_SETUP
#undef U_BLOADS
#undef U_MFMA
    }
}
typedef float f32x2v __attribute__((ext_vector_type(2)));
constexpr int NGRP_V = 8;
struct PvMeta { int R; v4u m[4]; };
__device__ __forceinline__ PvMeta pv_meta(const Args& A, int l, int t, int ntok, int lane) {
    PvMeta M; const int tt = t < ntok ? t : 0; M.R = peer_row(l, tt);
    const v4u* mp = (const v4u*)((const unsigned*)(A.ws + WS_ACT) + (size_t)M.R * 128 + (lane >> 3) * 16);
#pragma unroll
    for (int q = 0; q < 4; ++q) M.m[q] = mp[q];
    return M;
}
#define PV_W(M, i) ((i) & 3) == 0 ? M.m[(i) >> 2].x : (((i) & 3) == 1 ? M.m[(i) >> 2].y : (((i) & 3) == 2 ? M.m[(i) >> 2].z : M.m[(i) >> 2].w))
#define PV_LOADS(W, M) do { _Pragma("unroll") for (int i = 0; i < 16; ++i) { const unsigned mw = PV_W(M, i); W[i] = BLD128(vrs, ((mw & amv) << 10) + lane16, soff); } } while (0)
typedef int i32x2v __attribute__((ext_vector_type(2)));
template <int OFF> __device__ __forceinline__ i32x2v tr4_read(int addr) {
    i32x2v r; asm volatile("ds_read_b64_tr_b4 %0, %1 offset:%2" : "=&v"(r) : "v"(addr), "i"(OFF) : "memory"); return r; }
__device__ __forceinline__ f32x4 pv_res_x(const Args& A, int R, int s, int lane) {
    const int col = s * 256 + lane * 4;
    const f32x2 w2 = *(const f32x2*)((const bf16*)(A.ws + WS_XS) + (size_t)R * 2048 + col); const unsigned wa = __float_as_uint(w2.x), wb = __float_as_uint(w2.y);
    return (f32x4){bflo(wa), bfhi(wa), bflo(wb), bfhi(wb)};
}
struct PvAct { v4u w[8]; };
__device__ __forceinline__ PvAct pv_act_load(const Args& A, int R, int lane) {
    PvAct P; const v4u* ap = (const v4u*)((const unsigned*)(A.ws + WS_ACT) + (size_t)R * 128 + (lane >> 4) * 32);
#pragma unroll
    for (int q = 0; q < 8; ++q) P.w[q] = ap[q];
    return P;
}
__device__ __forceinline__ i32x8v pv_act_operand(const PvAct& P, int lane, bool en, float* inv) {
    unsigned mx = 0u;
#pragma unroll
    for (int q = 0; q < 8; ++q) { mx = max(mx, P.w[q].x & 0x7fff0000u); mx = max(mx, P.w[q].y & 0x7fff0000u); mx = max(mx, P.w[q].z & 0x7fff0000u); mx = max(mx, P.w[q].w & 0x7fff0000u); }
    mx = max(mx, (unsigned)__shfl_xor((int)mx, 16)); mx = max(mx, (unsigned)__shfl_xor((int)mx, 32));
    int E = (int)(mx >> 23); E = E < 24 ? 24 : (E > 230 ? 230 : E);
    *inv = __uint_as_float((unsigned)(E - 7) << 23);
    const float S = en ? __uint_as_float((unsigned)(261 - E) << 23) : 0.f;
    const int row = lane & 15; int o[8];
#pragma unroll
    for (int q = 0; q < 8; ++q) { const float a0 = __uint_as_float(P.w[q].x & 0xffff0000u) * S, a1 = __uint_as_float(P.w[q].y & 0xffff0000u) * S, a2 = __uint_as_float(P.w[q].z & 0xffff0000u) * S, a3 = __uint_as_float(P.w[q].w & 0xffff0000u) * S;
        const int q1 = (int)f8x4(a0, a1, a2, a3);
        const f32x2v b01 = __builtin_amdgcn_cvt_pk_f32_fp8(q1, false), b23 = __builtin_amdgcn_cvt_pk_f32_fp8(q1, true);
        const int q2 = (int)f8x4(a0 - b01.x, a1 - b01.y, a2 - b23.x, a3 - b23.y);
        o[q] = row == 0 ? q1 : (row == 1 ? q2 : 0); }
    return (i32x8v){o[0], o[1], o[2], o[3], o[4], o[5], o[6], o[7]};
}
__device__ __forceinline__ PvMeta pv_meta_lds(const LAS unsigned char* ab, int R, int lane) { PvMeta M; M.R = R;
#pragma unroll
    for (int q = 0; q < 4; ++q) M.m[q] = *(const LAS v4u*)(ab + (lane >> 3) * 64 + q * 16);
    return M; }
__device__ __forceinline__ PvAct pv_act_lds(const LAS unsigned char* ab, int lane) { PvAct P;
#pragma unroll
    for (int q = 0; q < 8; ++q) P.w[q] = *(const LAS v4u*)(ab + (lane >> 4) * 128 + q * 16);
    return P; }
__device__ __forceinline__ void phase_peer_v(const Args& A, const Frame& F0, int l, int pmode = 0) {
    const Frame F = refresh(F0);
    const unsigned amv = pmode == 1 ? 63u : 0xffffu;
    const int lane = F.lane;
    const int nvx = F.pnx, vx = F.px, rank = F.prank, nrank = F.pcnt;
    const int ntok = l == 0 ? MROWS : NB * SEQL;
    const unsigned char* V4 = (const unsigned char*)(A.ws + WS_V8) + (size_t)l * NEXP * 1024;
    const rsrc_t vrs = mk_rsrc(V4, (unsigned)NEXP * 1024u); const unsigned lane16 = (unsigned)(lane & 7) * 16u;
    const int stride = nrank * NWAVES, t0 = rank * NWAVES + F.wave;
    const bool en = (DBG & (l == 0 ? 8 : 32)) != 0;
    const int g = lane >> 3, c = lane & 7, j = lane & 15, kg = lane >> 4;
    LAS unsigned char* tl = F.lds + F.wave * 16384;
    const int tile = (int)(uintptr_t)(F.ldsg + F.wave * 16384);
    int wbs[8], rbs[8];
#pragma unroll
    for (int k = 0; k < 8; ++k) { wbs[k] = ((g & 1) * 64 + (g >> 1) * 16) * 128 + ((c ^ k) * 16); rbs[k] = tile + (32 * kg + j) * 128 + ((k ^ ((j >> 1) & 7)) * 16); }
    int sc1 = 127; asm volatile("" : "+v"(sc1));
    for (int s = vx; s < NGRP_V; s += nvx) {
        const int soff = __builtin_amdgcn_readfirstlane(s * 128);
        const unsigned* ACTp = (const unsigned*)(A.ws + WS_ACT);
#define PV_RAW(t_) (*(const f32x2*)(ACTp + (size_t)peer_row(l, (t_) < ntok ? (t_) : 0) * 128 + lane * 2))
        LAS unsigned char* ab = F.lds + RING_BYTES + 1024 + F.wave * 1024;
        { const f32x2 r0 = PV_RAW(t0), r1 = PV_RAW(t0 + stride); *(LAS f32x2*)(ab + lane * 8) = r0; *(LAS f32x2*)(ab + 512 + lane * 8) = r1; }
        f32x2 rawn = PV_RAW(t0 + 2 * stride);
        PvMeta mc = pv_meta_lds(ab, peer_row(l, t0 < ntok ? t0 : 0), lane), mn = pv_meta_lds(ab + 512, peer_row(l, t0 + stride < ntok ? t0 + stride : 0), lane);
        v4u W[16];
        float invc; i32x8v aop = pv_act_operand(pv_act_lds(ab, lane), lane, en, &invc);
        PV_LOADS(W, mc);
        int cR = mc.R, par = 0, gmrow = -1; f32x4 ggc = {0.f, 0.f, 0.f, 0.f};
        for (int t = t0; t < ntok; t += stride) {
#pragma unroll
            for (int i = 0; i < 16; ++i) { *(LAS v4u*)(tl + wbs[(i >> 1) & 7] + i * 128) = W[i]; const unsigned mw = PV_W(mn, i); W[i] = BLD128(vrs, ((mw & amv) << 10) + lane16, soff); }
            const f32x4 prx = pv_res_x(A, cR, s, lane);
            { const int tp_ = cR % TPB, mrow = tp_ < CTXL ? 8 : cR / TPB;
              if (mrow != gmrow) { gmrow = mrow; ggc = *(const f32x4*)((const float*)(A.ws + WS_MOD) + (size_t)(l * 9 + mrow) * 12288 + 5 * 2048 + s * 256 + lane * 4); } }
            __builtin_amdgcn_sched_barrier(0);
            asm volatile("s_waitcnt lgkmcnt(0)" ::: "memory");
            float res[16];
#define PV_TR(B_, gq_) do { _Pragma("unroll") for (int q_ = 0; q_ < 4; ++q_) { constexpr int dummy_ = 0; (void)dummy_; } \
                B_[0] = tr4_read<((4 * (gq_) + 0) & 1) * 8>(rbs[(4 * (gq_) + 0) >> 1]); B_[1] = tr4_read<2048 + ((4 * (gq_) + 0) & 1) * 8>(rbs[(4 * (gq_) + 0) >> 1]); \
                B_[2] = tr4_read<((4 * (gq_) + 1) & 1) * 8>(rbs[(4 * (gq_) + 1) >> 1]); B_[3] = tr4_read<2048 + ((4 * (gq_) + 1) & 1) * 8>(rbs[(4 * (gq_) + 1) >> 1]); \
                B_[4] = tr4_read<((4 * (gq_) + 2) & 1) * 8>(rbs[(4 * (gq_) + 2) >> 1]); B_[5] = tr4_read<2048 + ((4 * (gq_) + 2) & 1) * 8>(rbs[(4 * (gq_) + 2) >> 1]); \
                B_[6] = tr4_read<((4 * (gq_) + 3) & 1) * 8>(rbs[(4 * (gq_) + 3) >> 1]); B_[7] = tr4_read<2048 + ((4 * (gq_) + 3) & 1) * 8>(rbs[(4 * (gq_) + 3) >> 1]); } while (0)
#define PV_MM4(B_, D_) do { _Pragma("unroll") for (int q_ = 0; q_ < 4; ++q_) { const i32x4v bop_ = {B_[2 * q_].x, B_[2 * q_].y, B_[2 * q_ + 1].x, B_[2 * q_ + 1].y}; \
                asm volatile("v_mfma_scale_f32_16x16x128_f8f6f4 %0, %1, %2, 0, %3, %4 op_sel_hi:[0,0,0] blgp:4" : "=&v"(D_[q_]) : "v"(aop), "v"(bop_), "v"(sc1), "v"(sc1)); } } while (0)
#define PV_RES(D_, gq_) do { _Pragma("unroll") for (int q_ = 0; q_ < 4; ++q_) res[4 * (gq_) + q_] = D_[q_].x + D_[q_].y; } while (0)
            { i32x2v ba[8], bb[8]; f32x4 da[4], db[4];
              PV_TR(ba, 0);
              PV_TR(bb, 1); asm volatile("s_waitcnt lgkmcnt(8)" ::: "memory"); PV_MM4(ba, da);
              PV_TR(ba, 2); asm volatile("s_waitcnt lgkmcnt(8)" ::: "memory"); PV_MM4(bb, db); asm volatile("s_nop 7" ::: "memory"); PV_RES(da, 0);
              PV_TR(bb, 3); asm volatile("s_waitcnt lgkmcnt(8)" ::: "memory"); PV_MM4(ba, da); asm volatile("s_nop 7" ::: "memory"); PV_RES(db, 1);
              asm volatile("s_waitcnt lgkmcnt(0)" ::: "memory"); PV_MM4(bb, db); asm volatile("s_nop 7" ::: "memory"); PV_RES(da, 2);
              asm volatile("s_nop 15\n\ts_nop 7" ::: "memory"); PV_RES(db, 3); }
#undef PV_TR
#undef PV_MM4
#undef PV_RES
            if (lane < 16) {
#pragma unroll
                for (int nb = 0; nb < 16; ++nb) ((LAS float*)tl)[nb * 16 + j] = res[nb]; }
            asm volatile("s_waitcnt lgkmcnt(0)" ::: "memory");
            const f32x4 ov = *(const LAS f32x4*)(tl + lane * 16);
            asm volatile("s_waitcnt lgkmcnt(0)" ::: "memory");
            { const int R = cR, b = R / TPB, tp = R % TPB; const int col = s * 256 + lane * 4;
              f32x4 xo = {prx.x + ggc.x * (ov.x * invc), prx.y + ggc.y * (ov.y * invc), prx.z + ggc.z * (ov.z * invc), prx.w + ggc.w * (ov.w * invc)};
#if DBG_CHECK
              if (l == 1) { const float cs_ = 1.f + chk_code(A); xo = xo * cs_; }
#endif
              if (l == 0) { f32x2 o2; o2.x = __uint_as_float(pk2(xo.x, xo.y)); o2.y = __uint_as_float(pk2(xo.z, xo.w)); *(f32x2*)((bf16*)(A.ws + WS_XS) + (size_t)R * 2048 + col) = o2; }
              else *(f32x4*)(A.out + (size_t)(b * SEQL + tp - CTXL) * 2048 + col) = xo; }
            aop = pv_act_operand(pv_act_lds(ab + (par ^ 1) * 512, lane), lane, en, &invc);
            cR = mn.R;
            *(LAS f32x2*)(ab + par * 512 + lane * 8) = rawn;
            mn = pv_meta_lds(ab + par * 512, peer_row(l, t + 2 * stride < ntok ? t + 2 * stride : 0), lane);
            rawn = PV_RAW(t + 3 * stride);
            par ^= 1;
        }
#undef PV_RAW
    }
}

constexpr int N_PHASES = 24;
__global__ void __launch_bounds__(NTHR, 2) mega_fwd(Args args) {
    extern __shared__ __attribute__((aligned(16))) unsigned char lds[];
    Frame F;
    F.lds = (LAS unsigned char*)lds; F.ldsg = lds;
    F.tid = threadIdx.x; F.lane = F.tid & 63; F.wave = __builtin_amdgcn_readfirstlane(F.tid >> 6);
    F.G = gridDim.x; { const int bx = blockIdx.x; F.vcu = (F.G % 8 == 0) ? (bx % 8) * (F.G / 8) + bx / 8 : bx; }
    for (int u = F.tid; u < (LDS_BYTES - LDSCTL_OFF) / 4; u += NTHR) ((LAS unsigned*)(F.lds + LDSCTL_OFF))[u] = 0u;
    __syncthreads();
    volatile LAS unsigned* MISC = (volatile LAS unsigned*)(F.lds + MISC_OFF);
    XcdBarrier bar = xcd_barrier_post((unsigned*)(args.ws + WS_CTL) + CW_BAR + args.li * XCD_BAR_WORDS, MISC + 8);
    unsigned char* ws = args.ws;
    const int lo = args.ph_lo, hi = args.ph_hi;
    { const int nvx_ = (F.G % 8 == 0) ? 8 : 1; F.pnx = nvx_; F.px = (int)blockIdx.x % nvx_; F.prank = (int)blockIdx.x / nvx_; F.pcnt = F.G / nvx_; }
#define PH(k) (lo <= (k) && (k) < hi)
#define SEAM(k) do { if (PH(k) && PH((k) + 1)) xcd_barrier(bar); } while (0)
#ifndef REP_MASK
#define REP_MASK 0
#endif
#ifndef PROBE_P
#define PROBE_P 1
#endif
#ifndef PROBE_B
#define PROBE_B 0
#endif
#ifndef PROBE_E
#define PROBE_E 1
#endif
#ifndef PROBE_K
#define PROBE_K 1024
#endif
#ifndef PROBE_A
#define PROBE_A 2
#endif
#ifndef PROBE_U
#define PROBE_U 0
#endif
#define NREP(bit) ((REP_MASK >> (bit)) & 1 ? 2 : 1)
#define REPEAT(bit) for (int rep_ = 0; rep_ < NREP(bit); ++rep_)
#define FILLER(S, j0, j1) do { const int rounds_ = ((S).total + F.G - 1) / F.G, nb_ = (S).total - (rounds_ - 1) * F.G, c_ = (int)blockIdx.x; \
    if (nb_ >= F.G) quant_fill(args, F, j0, j1, c_, F.G); else if (c_ >= nb_) quant_fill(args, F, j0, j1, c_ - nb_, F.G - nb_); } while (0)
    REPEAT(0) { if (PH(0)) phase_prologue(args, F, (NREP(0) == 2 && rep_ == 0) ? PROBE_P : 0);
    SEAM(0); }
    if (PH(1)) phase_rownorm(args, F, 0, 0, true);
    SEAM(1);
    for (int xb_ = 0; xb_ < PROBE_B; ++xb_) xcd_barrier(bar);
    for (int l = 0; l < 2; ++l) {
        const int pb = 2 + 11 * l;
        REPEAT(1) {
        if (PH(pb + 0)) { pg8::Gemm g{(const pg8::bf16_t*)(ws + WS_HN), (const pg8::bf16_t*)(ws + WS_WIN + (size_t)l * 4608 * 2048), MROWS, INC, (NREP(1) == 2 && rep_ == 0) ? PROBE_K : 1024};
          pg8::SegOrder S; if (l == 0) S.init(F.G, (int)blockIdx.x, 0, 0, 18, 2, 9, 0); else S.init(F.G, (int)blockIdx.x, 1, 0, 18, 2, 9, 9);
          pg8::EpiQKV E{(pg8::bf16_t*)(ws + WS_QKV), (NREP(1) == 2 && rep_ == 0 && PROBE_E) ? nullptr : (const float*)(ws + WS_GAINS) + l * 512, (const float*)(ws + WS_ROPE), (PG8_LAS float*)(F.lds + RING_BYTES + 1024)};
          pg8::gemm_phase<pg8::EpiQKV, pg8::SegOrder, true, true, true>(F.lds, g, S, E, F.wave);
          if (l == 0 && rep_ == 0) { FILLER(S, 0, 18300); } }
        SEAM(pb + 0); }
        REPEAT(2) { if (PH(pb + 2)) phase_attention(args, F, l, (NREP(2) == 2 && rep_ == 0) ? PROBE_A : 7);
        SEAM(pb + 2); }
        REPEAT(8) { if (PH(pb + 3)) { phase_retention_out(args, F, l);
          if (l == 0 && rep_ == 0) { const int rounds_ = (288 + F.G - 1) / F.G, nb_ = 288 - (rounds_ - 1) * F.G;
            if (nb_ >= F.G) quant_fill(args, F, 18300, 26300, F.vcu, F.G); else if (F.vcu >= nb_) quant_fill(args, F, 18300, 26300, F.vcu - nb_, F.G - nb_); } }
        SEAM(pb + 3); }
        for (int rep_ = 0; rep_ < (l == 0 ? NREP(3) : 1); ++rep_) {
        if (PH(pb + 4)) { pg8::Gemm g{(const pg8::bf16_t*)(ws + WS_CAT), (const pg8::bf16_t*)(ws + WS_WOUT + (size_t)l * 2048 * 2048), MROWS, 2048, 1024};
          pg8::SegOrder S; S.init(F.G, (int)blockIdx.x, l == 0 ? 0 : 1, 0, 8, 2, 0, 0);
          pg8::EpiResid E{l == 0 ? args.in[IN_X] : nullptr, args.in[IN_CTX], (pg8::bf16_t*)(ws + WS_XS), (const float*)(ws + WS_MOD) + (size_t)l * 9 * 12288 + 2 * 2048, (l == 1 && !(DBG & 16)) ? 0.f : 1.f};
          pg8::gemm_phase<pg8::EpiResid, pg8::SegOrder, true, true, true>(F.lds, g, S, E, F.wave);
          if (l == 0 && rep_ == 0) { FILLER(S, 26300, 46400); } }
        SEAM(pb + 4); }
        REPEAT(9) { if (PH(pb + 5)) phase_rownorm(args, F, l, 1, l == 0);
        SEAM(pb + 5); }
        REPEAT(4) {
        if (PH(pb + 6)) { pg8::Gemm g{(const pg8::bf16_t*)(ws + WS_HN), (const pg8::bf16_t*)(ws + WS_WPQ) + (size_t)l * 2048 * 2048, MROWS, 2048, 2048};
          pg8::SegOrder S; S.init(F.G, (int)blockIdx.x, l == 0 ? 0 : 1, 0, 8, 2, 0, 0);
          pg8::EpiQP E{(pg8::bf16_t*)(ws + WS_QKV)};
          pg8::gemm_phase<pg8::EpiQP, pg8::SegOrder, true, true, false>(F.lds, g, S, E, F.wave);
          if (l == 0 && rep_ == 0) { FILLER(S, 46400, 65536); } }
        SEAM(pb + 6); }
        REPEAT(7) { if (PH(pb + 7)) phase_peer_topk(args, F, l);
        SEAM(pb + 7); }
        REPEAT(5) { if (PH(pb + 8)) phase_peer_u(args, F, l, (NREP(5) == 2 && rep_ == 0) ? PROBE_U : 0);
        SEAM(pb + 8); }
        for (int rep_ = 0; rep_ < (l == 1 ? NREP(6) : 1); ++rep_) { if (PH(pb + 9)) phase_peer_v(args, F, l, (l == 1 && NREP(6) == 2 && rep_ == 0) ? PROBE_U : 0);
        if (rep_ + 1 < (l == 1 ? NREP(6) : 1)) xcd_barrier(bar); }
        SEAM(pb + 9);
        if (PH(pb + 10) && l == 0) phase_rownorm(args, F, 1, 2, true);
        SEAM(pb + 10);
    }
#undef PH
#undef SEAM
}
#if DBG_CHECK
__global__ void __launch_bounds__(NTHR) chk_kernel(Args args, int which) {
    if (which == 0) { chk_save(args, threadIdx.x); __syncthreads(); __threadfence(); chk_qp_topk(args, threadIdx.x); }
    else chk_experts(args, threadIdx.x);
}
#endif

extern "C" void kernel_launch(void* const* d_in, const int* in_sizes, int n_in, void* d_out, int out_size, void* d_ws, size_t ws_size, hipStream_t stream) {
    static int grid = 0;
    if (grid == 0) {
        if (n_in != 22 || ws_size < WS_END) { fprintf(stderr, "kernel_launch: unexpected n_in %d / ws_size %zu (need %zu)\n", n_in, ws_size, (size_t)WS_END); grid = -1; return; }
        int dev = 0, cus = 0, per_cu = 0;
        (void)hipGetDevice(&dev);
        (void)hipDeviceGetAttribute(&cus, hipDeviceAttributeMultiprocessorCount, dev);
        if (hipFuncSetAttribute((const void*)mega_fwd, hipFuncAttributeMaxDynamicSharedMemorySize, LDS_BYTES) != hipSuccess) { fprintf(stderr, "kernel_launch: hipFuncSetAttribute failed\n"); grid = -1; return; }
        (void)hipOccupancyMaxActiveBlocksPerMultiprocessor(&per_cu, (const void*)mega_fwd, NTHR, LDS_BYTES);
        (void)hipGetLastError();
        if (per_cu < 1) fprintf(stderr, "kernel_launch: occupancy query says %d blocks per CU\n", per_cu);
        grid = cus > 0 ? cus : 256;
    }
    if (grid < 0) return;
    (void)hipMemsetAsync((char*)d_ws + WS_CTL, 0, CTL_ZERO_BYTES, stream);
    Args a{};
    for (int i = 0; i < 22; ++i) a.in[i] = (const float*)d_in[i];
    a.out = (float*)d_out; a.ws = (unsigned char*)d_ws;
#if DBG_CHECK
    const int cuts[4] = {0, 10, 12, N_PHASES};
    for (int li = 0; li < 3; ++li) {
        a.ph_lo = cuts[li]; a.ph_hi = cuts[li + 1]; a.li = li;
        void* kargs[] = {&a};
        hipError_t e = hipLaunchCooperativeKernel((const void*)mega_fwd, dim3(grid), dim3(NTHR), kargs, LDS_BYTES, stream);
        if (e != hipSuccess) fprintf(stderr, "kernel_launch: cooperative launch failed: %s (grid %d)\n", hipGetErrorString(e), grid);
        if (li < 2) hipLaunchKernelGGL(chk_kernel, dim3(1), dim3(NTHR), 0, stream, a, li);
    }
#else
    a.ph_lo = 0; a.ph_hi = N_PHASES; a.li = 0;
    void* kargs[] = {&a};
    hipError_t e = hipLaunchCooperativeKernel((const void*)mega_fwd, dim3(grid), dim3(NTHR), kargs, LDS_BYTES, stream);
    if (e != hipSuccess) fprintf(stderr, "kernel_launch: cooperative launch failed: %s (grid %d)\n", hipGetErrorString(e), grid);
#endif
}
```
